# Optimizing an MI355X kernel written in HIP

```python
import math
import numpy as np
import jax
import jax.numpy as jnp
from jax import lax

D_MODEL = 1024
BATCH = 4
SEQ = 8192
DEPTH = 2

GRID_W = 64
CTX_LEN = 256
CHUNK = 64
S5_W = D_MODEL // 4
S5_HC = 16
S5_G = S5_W // S5_HC
S5_P = 64
GLA_W = 3 * D_MODEL // 8
GLA_H = 4
GLA_DV = GLA_W // GLA_H
GLA_DK = GLA_DV // 2
GLA_RANK = 16
GLA_TAU = 16.0
ML_W = 3 * D_MODEL // 8
ML_H = 4
ML_D = ML_W // ML_H
D_FF = ((8 * D_MODEL // 3 + 127) // 128) * 128
ALPHA = (2.0 * DEPTH) ** 0.25
BETA = (8.0 * DEPTH) ** -0.25
LN_EPS = 1e-5
IN_SPLITS = (S5_W, GLA_H * GLA_DK, GLA_H * GLA_DK, GLA_W, GLA_W, 2 * GLA_RANK, ML_W, ML_W, ML_W, ML_W, 2 * ML_H, 2 * ML_H)
D_IN = sum(IN_SPLITS)
IN_OFFSETS = tuple(int(o) for o in np.cumsum(IN_SPLITS)[:-1])

kernel_name = 'hybrid_s5_gla_mlstm_prefix_dit'


def _ln(x):
    xf = x.astype(jnp.float32)
    mu = jnp.mean(xf, axis=-1, keepdims=True)
    var = jnp.mean(jnp.square(xf - mu), axis=-1, keepdims=True)
    return (xf - mu) * lax.rsqrt(var + LN_EPS)


def _modulate(h, shift, scale):
    return (_ln(h) * (1.0 + scale) + shift).astype(h.dtype)


def _post_ln(y, g, b):
    return (_ln(y) * g + b).astype(y.dtype)


def _identity(t):
    return t


def _flip(t):
    return jnp.flip(t, axis=1)


def _bidir(run, ctx_in, lat_in, state0, ctx_out):
    y_x, y_c = None, None
    for d, fl in enumerate((_identity, _flip)):
        yc, st = run(tuple(fl(t) for t in ctx_in[d]), d, state0, ctx_out)
        yx, _ = run(tuple(fl(t) for t in lat_in[d]), d, st, True)
        y_x = fl(yx) if y_x is None else y_x + fl(yx)
        if ctx_out:
            y_c = fl(yc) if y_c is None else y_c + fl(yc)
    return y_x, y_c


def _cplx_combine(e1, e2):
    a1r, a1i, b1r, b1i = e1
    a2r, a2i, b2r, b2i = e2
    ar = a2r * a1r - a2i * a1i
    ai = a2r * a1i + a2i * a1r
    br = a2r * b1r - a2i * b1i + b2r
    bi = a2r * b1i + a2i * b1r + b2i
    return ar, ai, br, bi


def _s5_scan(u, a_re, a_im, log_dt, b_re, b_im, s0):
    dt = jnp.exp(log_dt)[:, None]
    mag = jnp.exp(a_re * dt)
    lam_re = mag * jnp.cos(a_im * dt)
    lam_im = mag * jnp.sin(a_im * dt)
    den = a_re * a_re + a_im * a_im
    z_re = ((lam_re - 1.0) * a_re + lam_im * a_im) / den
    z_im = (lam_im * a_re - (lam_re - 1.0) * a_im) / den
    bb_re = z_re[..., None] * b_re - z_im[..., None] * b_im
    bb_im = z_re[..., None] * b_im + z_im[..., None] * b_re
    bu_re = jnp.einsum('gph,blgh->blgp', bb_re, u)
    bu_im = jnp.einsum('gph,blgh->blgp', bb_im, u)
    s_re, s_im = s0
    bu_re = bu_re.at[:, 0].add(lam_re * s_re - lam_im * s_im)
    bu_im = bu_im.at[:, 0].add(lam_re * s_im + lam_im * s_re)
    la_re = jnp.broadcast_to(lam_re, bu_re.shape)
    la_im = jnp.broadcast_to(lam_im, bu_im.shape)
    _, _, x_re, x_im = lax.associative_scan(_cplx_combine, (la_re, la_im, bu_re, bu_im), axis=1)
    return x_re, x_im


def _s5_mixer(ux, uc, a_re, a_im, log_dt, b_re, b_im, c_re, c_im, d_skip, w_glu, b_glu, ctx_out):
    f32 = jnp.float32
    a_re, a_im, log_dt, b_re, b_im, c_re, c_im, d_skip = (
        t.astype(f32) for t in (a_re, a_im, log_dt, b_re, b_im, c_re, c_im, d_skip))

    def grp(u):
        return u.astype(f32).reshape(u.shape[0], u.shape[1], S5_G, S5_HC)

    gx, gc = grp(ux), grp(uc)

    def run(inp, d, s0, want_out):
        (u,) = inp
        x_re, x_im = _s5_scan(u, a_re[d], a_im[d], log_dt[d], b_re[d], b_im[d], s0)
        final = (x_re[:, -1], x_im[:, -1])
        if not want_out:
            return None, final
        y = jnp.einsum('ghp,blgp->blgh', c_re[d], x_re) - jnp.einsum('ghp,blgp->blgh', c_im[d], x_im)
        return y, final

    zeros = jnp.zeros((gc.shape[0], S5_G, S5_P), f32)
    yx, yc = _bidir(run, [(gc,), (gc,)], [(gx,), (gx,)], (zeros, zeros), ctx_out)

    def post(y, u):
        B_, L = y.shape[:2]
        y = jax.nn.gelu((y + d_skip.reshape(S5_G, S5_HC) * u).reshape(B_, L, S5_W))
        return y * jax.nn.sigmoid(y @ w_glu + b_glu)

    return post(yx, gx), (post(yc, gc) if ctx_out else None)


def _gla_dir(q, k, v, loga, S0, want_out):
    B_, L, H, DK = q.shape
    DV = v.shape[-1]
    N = L // CHUNK
    q, k, loga = (t.reshape(B_, N, CHUNK, H, DK) for t in (q, k, loga))
    v = v.reshape(B_, N, CHUNK, H, DV)
    b = jnp.cumsum(loga, axis=2)
    b_last = b[:, :, -1]
    dS = jnp.einsum('bnshk,bnshv->bnhkv', k * jnp.exp(b_last[:, :, None] - b), v)

    def step(S, inp):
        decay, ds = inp
        return decay[..., None] * S + ds, S

    S_final, S_enter = lax.scan(step, S0, (jnp.moveaxis(jnp.exp(b_last), 1, 0), jnp.moveaxis(dS, 1, 0)))
    if not want_out:
        return None, S_final
    S_enter = jnp.moveaxis(S_enter, 0, 1)
    qd = q * jnp.exp(b)
    causal = jnp.tril(jnp.ones((CHUNK, CHUNK), dtype=bool))
    att = jnp.einsum('bnthk,bnshk->bnhts', qd, k * jnp.exp(-b))
    att = jnp.where(causal, att, 0.0)
    o = jnp.einsum('bnthk,bnhkv->bnthv', qd, S_enter) + jnp.einsum('bnhts,bnshv->bnthv', att, v)
    return o.reshape(B_, L, H, DV), S_final


def _gla_mixer(parts_x, parts_c, w_a2, b_a, g, ctx_out):
    f32 = jnp.float32
    w_a2, b_a, g = (t.astype(f32) for t in (w_a2, b_a, g))

    def prep(parts):
        q, k, v, r, lr = (t.astype(f32) for t in parts)
        B_, L, _ = q.shape
        q = q.reshape(B_, L, GLA_H, GLA_DK) * GLA_DK ** -0.5
        k = k.reshape(B_, L, GLA_H, GLA_DK)
        v = v.reshape(B_, L, GLA_H, GLA_DV)
        z = jnp.einsum('blzr,zrk->blzk', lr.reshape(B_, L, 2, GLA_RANK), w_a2) + b_a
        loga = (jax.nn.log_sigmoid(z) / GLA_TAU).reshape(B_, L, 2, GLA_H, GLA_DK)
        return [(q, k, v, loga[:, :, d]) for d in range(2)], r

    ins_x, r_x = prep(parts_x)
    ins_c, r_c = prep(parts_c)

    def run(inp, d, s0, want_out):
        return _gla_dir(*inp, s0, want_out)

    S0 = jnp.zeros((r_c.shape[0], GLA_H, GLA_DK, GLA_DV), f32)
    ox, oc = _bidir(run, ins_c, ins_x, S0, ctx_out)

    def post(o, r):
        B_, L = r.shape[:2]
        return jax.nn.silu(r) * (_ln(o) * g.reshape(GLA_H, GLA_DV)).reshape(B_, L, GLA_W)

    return post(ox, r_x), (post(oc, r_c) if ctx_out else None)


def _mlstm_dir(q, k, v, ig, lf, state0, want_out):
    B_, L, H, DK = q.shape
    DV = v.shape[-1]
    N = L // CHUNK
    q, k = (t.reshape(B_, N, CHUNK, H, DK) for t in (q, k))
    v = v.reshape(B_, N, CHUNK, H, DV)
    ig, lf = (t.reshape(B_, N, CHUNK, H) for t in (ig, lf))
    F = jnp.cumsum(lf, axis=2)
    F_last = F[:, :, -1]
    g = F_last[:, :, None] - F + ig
    m_loc = jnp.max(g, axis=2)
    w = jnp.exp(g - m_loc[:, :, None])
    dC = jnp.einsum('bnsh,bnshk,bnshv->bnhkv', w, k, v)
    dn = jnp.einsum('bnsh,bnshk->bnhk', w, k)

    def step(carry, inp):
        C, n, m = carry
        fl, ml, dc, dnn = inp
        m_new = jnp.maximum(fl + m, ml)
        a = jnp.exp(fl + m - m_new)
        bb = jnp.exp(ml - m_new)
        C_new = a[..., None, None] * C + bb[..., None, None] * dc
        n_new = a[..., None] * n + bb[..., None] * dnn
        return (C_new, n_new, m_new), (C, n, m)

    xs = tuple(jnp.moveaxis(t, 1, 0) for t in (F_last, m_loc, dC, dn))
    final, enter = lax.scan(step, state0, xs)
    if not want_out:
        return None, final
    C_e, n_e, m_e = (jnp.moveaxis(t, 0, 1) for t in enter)
    causal = jnp.tril(jnp.ones((CHUNK, CHUNK), dtype=bool))
    Dlog = F[:, :, :, None, :] - F[:, :, None, :, :] + ig[:, :, None, :, :]
    Dlog = jnp.where(causal[None, None, :, :, None], Dlog, -jnp.inf)
    inter = F + m_e[:, :, None]
    m_t = jnp.maximum(inter, jnp.max(Dlog, axis=3))
    w_inter = jnp.exp(inter - m_t)
    P = jnp.exp(Dlog - m_t[:, :, :, None]) * jnp.einsum('bnthk,bnshk->bntsh', q, k)
    num = w_inter[..., None] * jnp.einsum('bnthk,bnhkv->bnthv', q, C_e) + jnp.einsum('bntsh,bnshv->bnthv', P, v)
    den = w_inter * jnp.einsum('bnthk,bnhk->bnth', q, n_e) + jnp.sum(P, axis=3)
    h = num / jnp.maximum(jnp.abs(den), jnp.exp(-m_t))[..., None]
    return h.reshape(B_, L, H, DV), final


def _mlstm_mixer(parts_x, parts_c, i_bias, f_bias, g, ctx_out):
    f32 = jnp.float32
    i_bias, f_bias, g = (t.astype(f32) for t in (i_bias, f_bias, g))

    def prep(parts):
        q, k, v, o, ig, fg = (t.astype(f32) for t in parts)
        B_, L, _ = q.shape
        q = q.reshape(B_, L, ML_H, ML_D)
        k = k.reshape(B_, L, ML_H, ML_D) * ML_D ** -0.5
        v = v.reshape(B_, L, ML_H, ML_D)
        ig = ig.reshape(B_, L, 2, ML_H) + i_bias
        lf = jax.nn.log_sigmoid(fg.reshape(B_, L, 2, ML_H) + f_bias)
        return [(q, k, v, ig[:, :, d], lf[:, :, d]) for d in range(2)], o

    ins_x, o_x = prep(parts_x)
    ins_c, o_c = prep(parts_c)
    Bc = o_c.shape[0]
    state0 = (jnp.zeros((Bc, ML_H, ML_D, ML_D), f32), jnp.zeros((Bc, ML_H, ML_D), f32), jnp.zeros((Bc, ML_H), f32))

    def run(inp, d, s0, want_out):
        return _mlstm_dir(*inp, s0, want_out)

    hx, hc = _bidir(run, ins_c, ins_x, state0, ctx_out)

    def post(h, o):
        B_, L = o.shape[:2]
        return jax.nn.sigmoid(o) * (_ln(h) * g.reshape(ML_H, ML_D)).reshape(B_, L, ML_W)

    return post(hx, o_x), (post(hc, o_c) if ctx_out else None)


def _token_mixers(zx, zc, s5_a_re, s5_a_im, s5_log_dt, s5_b_re, s5_b_im, s5_c_re, s5_c_im, s5_d,
                  s5_w_glu, s5_b_glu, gla_w_a2, gla_b_a, gla_g, ml_i_bias, ml_f_bias, ml_g, ctx_out):
    px = jnp.split(zx, IN_OFFSETS, axis=-1)
    pc = jnp.split(zc, IN_OFFSETS, axis=-1)
    s5x, s5c = _s5_mixer(px[0], pc[0], s5_a_re, s5_a_im, s5_log_dt, s5_b_re, s5_b_im, s5_c_re, s5_c_im,
                         s5_d, s5_w_glu, s5_b_glu, ctx_out)
    glx, glc = _gla_mixer(px[1:6], pc[1:6], gla_w_a2, gla_b_a, gla_g, ctx_out)
    mlx, mlc = _mlstm_mixer(px[6:12], pc[6:12], ml_i_bias, ml_f_bias, ml_g, ctx_out)
    out_x = jnp.concatenate([s5x, glx, mlx], axis=-1).astype(zx.dtype)
    out_c = jnp.concatenate([s5c, glc, mlc], axis=-1).astype(zc.dtype) if ctx_out else None
    return out_x, out_c


def _conv_ffn(h, w_up, w_dconv, b_dconv, w_down, rows):
    B_, L, _ = h.shape
    a, v = jnp.split(h @ w_up, 2, axis=-1)
    a = a.reshape(B_, rows, L // rows, D_FF)
    a = lax.conv_general_dilated(a, w_dconv[:, :, None, :], (1, 1), 'SAME',
                                 dimension_numbers=('NHWC', 'HWIO', 'NHWC'), feature_group_count=D_FF)
    a = a.reshape(B_, L, D_FF) + b_dconv
    return (jax.nn.gelu(a) * v) @ w_down


def setup_inputs(seed: int = 0) -> dict:
    key = jax.random.key(seed)
    ks = iter(jax.random.split(key, 48))
    f32 = jnp.float32

    def nrm(shape, scale):
        return scale * jax.random.normal(next(ks), shape, f32)

    Lh, D = DEPTH, D_MODEL
    n_idx = jnp.arange(S5_P, dtype=f32)
    return {
        'x': nrm((BATCH, SEQ, D), 1.0),
        'c': nrm((BATCH, D), 1.0),
        'ctx': nrm((BATCH, CTX_LEN, D), 1.0),
        'c_ctx': nrm((D,), 1.0),
        'w_ada': nrm((Lh, D, 6 * D), 0.5 * D ** -0.5),
        'b_ada': nrm((Lh, 6 * D), 0.02),
        'w_in': nrm((Lh, D, D_IN), D ** -0.5),
        's5_a_re': -0.5 * jnp.exp(nrm((Lh, 2, S5_G, S5_P), 0.05)),
        's5_a_im': math.pi * n_idx + nrm((Lh, 2, S5_G, S5_P), 0.05),
        's5_log_dt': jax.random.uniform(next(ks), (Lh, 2, S5_G), f32, math.log(1e-3), math.log(1e-1)),
        's5_b_re': nrm((Lh, 2, S5_G, S5_P, S5_HC), (2.0 * S5_HC) ** -0.5),
        's5_b_im': nrm((Lh, 2, S5_G, S5_P, S5_HC), (2.0 * S5_HC) ** -0.5),
        's5_c_re': nrm((Lh, 2, S5_G, S5_HC, S5_P), S5_P ** -0.5),
        's5_c_im': nrm((Lh, 2, S5_G, S5_HC, S5_P), S5_P ** -0.5),
        's5_d': nrm((Lh, S5_W), 1.0),
        's5_w_glu': nrm((Lh, S5_W, S5_W), S5_W ** -0.5),
        's5_b_glu': nrm((Lh, S5_W), 0.02),
        'gla_w_a2': nrm((Lh, 2, GLA_RANK, GLA_H * GLA_DK), GLA_RANK ** -0.5),
        'gla_b_a': nrm((Lh, 2, GLA_H * GLA_DK), 0.1),
        'gla_g': 1.0 + nrm((Lh, GLA_W), 0.02),
        'ml_i_bias': nrm((Lh, 2, ML_H), 0.1),
        'ml_f_bias': jnp.linspace(3.0, 6.0, ML_H, dtype=f32) + nrm((Lh, 2, ML_H), 0.1),
        'ml_g': 1.0 + nrm((Lh, ML_W), 0.02),
        'w_out': nrm((Lh, D, D), BETA * D ** -0.5),
        'ln1_g': 1.0 + nrm((Lh, D), 0.02),
        'ln1_b': nrm((Lh, D), 0.02),
        'w_up': nrm((Lh, D, 2 * D_FF), D ** -0.5),
        'w_dconv': nrm((Lh, 3, 3, D_FF), 1.0 / 3.0),
        'b_dconv': nrm((Lh, D_FF), 0.02),
        'w_down': nrm((Lh, D_FF, D), BETA * D_FF ** -0.5),
        'ln2_g': 1.0 + nrm((Lh, D), 0.02),
        'ln2_b': nrm((Lh, D), 0.02),
    }


def reference(x, c, ctx, c_ctx, w_ada, b_ada, w_in, s5_a_re, s5_a_im, s5_log_dt, s5_b_re, s5_b_im,
              s5_c_re, s5_c_im, s5_d, s5_w_glu, s5_b_glu, gla_w_a2, gla_b_a, gla_g, ml_i_bias, ml_f_bias,
              ml_g, w_out, ln1_g, ln1_b, w_up, w_dconv, b_dconv, w_down, ln2_g, ln2_b):
    rows = x.shape[1] // GRID_W
    hx, hc = x, ctx
    for l in range(DEPTH):
        last = l == DEPTH - 1
        mod_x = jax.nn.silu(c) @ w_ada[l] + b_ada[l]
        mod_c = jax.nn.silu(c_ctx) @ w_ada[l] + b_ada[l]
        sh1, sc1, g1, sh2, sc2, g2 = (m[:, None, :] for m in jnp.split(mod_x, 6, axis=-1))
        csh1, csc1, cg1, csh2, csc2, cg2 = jnp.split(mod_c, 6, axis=-1)
        zx = _modulate(hx, sh1, sc1) @ w_in[l]
        zc = _modulate(hc, csh1, csc1) @ w_in[l]
        mx, mc = _token_mixers(zx, zc, s5_a_re[l], s5_a_im[l], s5_log_dt[l], s5_b_re[l], s5_b_im[l],
                               s5_c_re[l], s5_c_im[l], s5_d[l], s5_w_glu[l], s5_b_glu[l], gla_w_a2[l],
                               gla_b_a[l], gla_g[l], ml_i_bias[l], ml_f_bias[l], ml_g[l], not last)
        hx = _post_ln(ALPHA * hx + g1 * (mx @ w_out[l]), ln1_g[l], ln1_b[l])
        fx = _conv_ffn(_modulate(hx, sh2, sc2), w_up[l], w_dconv[l], b_dconv[l], w_down[l], rows)
        hx = _post_ln(ALPHA * hx + g2 * fx, ln2_g[l], ln2_b[l])
        if not last:
            hc = _post_ln(ALPHA * hc + cg1 * (mc @ w_out[l]), ln1_g[l], ln1_b[l])
            fc = _conv_ffn(_modulate(hc, csh2, csc2), w_up[l], w_dconv[l], b_dconv[l], w_down[l], 1)
            hc = _post_ln(ALPHA * hc + cg2 * fc, ln2_g[l], ln2_b[l])
    return hx
```

```cpp
#include <hip/hip_runtime.h>
#include <hip/hip_cooperative_groups.h>
#include <cstdio>
namespace cg = cooperative_groups;

#ifndef COOP
#define COOP 0
#endif

#define LAS __attribute__((address_space(3)))
typedef unsigned short bf16_t;
typedef short bf16x8 __attribute__((ext_vector_type(8)));
typedef float f32x4 __attribute__((ext_vector_type(4)));
typedef float f32x2 __attribute__((ext_vector_type(2)));
typedef unsigned u32x4 __attribute__((ext_vector_type(4)));
typedef unsigned u32x2 __attribute__((ext_vector_type(2)));

constexpr int NTHR = 512;
constexpr int MROWS = 33792, LROWS = 32768, DM = 1024, ZLD = 3072, DFF = 2816, DIN = 2992;
constexpr int LDS_BYTES = 150 * 1024;
constexpr float ALPHA_C = 1.41421356237f;
constexpr int ZC_U5 = 0, ZC_GQ = 256, ZC_GK = 448, ZC_GV = 640, ZC_GR = 1024, ZC_GLR = 1408, ZC_MQ = 1440, ZC_MK = 1824, ZC_MV = 2208, ZC_MO = 2592, ZC_MIG = 2976, ZC_MFG = 2984;

struct Params {
    const float *x, *c, *ctx, *c_ctx, *w_ada, *b_ada, *w_in, *s5_a_re, *s5_a_im, *s5_log_dt, *s5_b_re, *s5_b_im, *s5_c_re, *s5_c_im, *s5_d, *s5_w_glu, *s5_b_glu,
        *gla_w_a2, *gla_b_a, *gla_g, *ml_i_bias, *ml_f_bias, *ml_g, *w_out, *ln1_g, *ln1_b, *w_up, *w_dconv, *b_dconv, *w_down, *ln2_g, *ln2_b;
    float* out;
    bf16_t *WinT, *WoutT, *WupT, *WdownT, *WgluT;
    float* mod;
    bf16_t *M2T, *McatT;
    float* L16;
    float* hc;
    bf16_t* A1;
    unsigned char* big;
    int ph_lo, ph_hi;
};

#define PRM const __attribute__((address_space(4))) Params&
constexpr size_t WS_WIN = 0;
constexpr size_t WS_WOUT = WS_WIN + 2ull * 3072 * 1024 * 2;
constexpr size_t WS_WUP = WS_WOUT + 2ull * 1024 * 1024 * 2;
constexpr size_t WS_WDOWN = WS_WUP + 2ull * 5632 * 1024 * 2;
constexpr size_t WS_WGLU = WS_WDOWN + 2ull * 1024 * 2816 * 2;
constexpr size_t WS_MOD = WS_WGLU + 2ull * 256 * 256 * 2;
constexpr size_t WS_M2T = WS_MOD + 2ull * 5 * 6144 * 4;
constexpr size_t WS_MCAT = WS_M2T + 2ull * 16 * 256 * 256 * 2;
constexpr size_t WS_L16 = WS_MCAT + 2ull * 16 * 256 * 512 * 2;
constexpr size_t WS_HC = WS_L16 + 2ull * 2 * 16 * 64 * 2 * 4;
constexpr size_t WS_A1 = WS_HC + 1024ull * 1024 * 4;
constexpr size_t WS_BIG = WS_A1 + (size_t)MROWS * 1024 * 2;
constexpr size_t BIG_BYTES = (size_t)MROWS * 5632 * 2;
constexpr size_t WS_END = WS_BIG + BIG_BYTES;
constexpr size_t BIG_Z = 0;
constexpr size_t BIG_OBUF = BIG_Z + (size_t)MROWS * ZLD * 2;
constexpr size_t BIG_LOC = BIG_OBUF + 2ull * MROWS * 768 * 2;
constexpr size_t BIG_XE = BIG_LOC + 2ull * 4 * 16 * 528 * 128 * 4;
constexpr size_t BIG_G5 = BIG_XE + 2ull * 4 * 528 * 16 * 128 * 2;
constexpr size_t BIG_Y = 0;
constexpr size_t BIG_A = 0;
constexpr size_t BIG_V = (size_t)MROWS * DFF * 2;
static_assert(BIG_G5 + (size_t)MROWS * 256 * 2 <= BIG_BYTES, "big map");

struct Ctx { int tid, bid, nb; };
__device__ __forceinline__ float bf2f(bf16_t b) { return __uint_as_float(((unsigned)b) << 16); }
__device__ __forceinline__ bf16_t f2bf(float f) { unsigned u = __float_as_uint(f); u += 0x7FFFu + ((u >> 16) & 1u); return (bf16_t)(u >> 16); }
__device__ __forceinline__ unsigned pk2(float lo, float hi) { return (unsigned)f2bf(lo) | ((unsigned)f2bf(hi) << 16); }
__device__ __forceinline__ float lo2f(unsigned w) { return __uint_as_float(w << 16); }
__device__ __forceinline__ float hi2f(unsigned w) { return __uint_as_float(w & 0xFFFF0000u); }
__device__ __forceinline__ float sigmoidf_(float x) { return 1.0f / (1.0f + __expf(-x)); }
__device__ __forceinline__ float logsigmoidf_(float x) { return fminf(x, 0.f) - log1pf(__expf(-fabsf(x))); }
__device__ __forceinline__ float gelu_tanh(float x) { const float u = 0.7978845608f * (x + 0.044715f * x * x * x); const float t = 1.0f - 2.0f / (__expf(2.0f * u) + 1.0f); return 0.5f * x * (1.0f + t); }
__device__ __forceinline__ float siluf_(float x) { return x / (1.0f + __expf(-x)); }
__device__ __forceinline__ int mod_row(int row) { return row < LROWS ? (row >> 13) : 4; }
__device__ __forceinline__ float wave_sum(float v) {
#pragma unroll
    for (int o = 32; o > 0; o >>= 1) v += __shfl_xor(v, o, 64);
    return v;
}
__device__ __forceinline__ float wave_max(float v) {
#pragma unroll
    for (int o = 32; o > 0; o >>= 1) v = fmaxf(v, __shfl_xor(v, o, 64));
    return v;
}
__device__ __forceinline__ f32x4 mfma16(bf16x8 a, bf16x8 b, f32x4 c) { return __builtin_amdgcn_mfma_f32_16x16x32_bf16(a, b, c, 0, 0, 0); }

namespace pg8 {
constexpr int BM = 256, BK = 64, HALF = 128, HTB = HALF * BK * 2, STAGE_BYTES = 8 * HTB, NXCD = 8, WGM = 8;
__device__ __forceinline__ int lds_byte(int r, int c) { const int st = (r >> 4) * 2 + (c >> 5), rr = r & 15, cc = c & 31, ob = rr * 64 + cc * 2; return st * 1024 + (ob ^ (((ob >> 9) & 1) << 5)); }
__device__ __forceinline__ void stage_rc(int b, int& R, int& C) { const int st = b / 1024, sb = b % 1024, swz = sb ^ (((sb >> 9) & 1) << 5); R = (st >> 1) * 16 + swz / 64; C = (st & 1) * 32 + (swz % 64) / 2; }
__device__ __forceinline__ int perm32(int rho) { const int n = rho >> 4, i = rho & 15; return 8 * (i >> 2) + 4 * n + (i & 3); }
struct Unit { int pm, pn; };
struct Gemm { const bf16_t* A; const bf16_t* Bt; int M, N, K; };
struct StaticOrder {
    int nM, nN, nwg, G, c;
    __device__ void init(int M, int N, int G_, int c_) { nM = M / BM; nN = N / BM; nwg = nM * nN; G = G_; c = c_; }
    __device__ bool next(int i, Unit& u) const {
        const long L = (long)i * G + c; if (L >= nwg) return false;
        int wgid = (int)L; { const int q = nwg / NXCD, r = nwg % NXCD, xcd = wgid % NXCD, off = wgid / NXCD; wgid = (xcd < r ? xcd * (q + 1) : r * (q + 1) + (xcd - r) * q) + off; }
        const int nig = WGM * nN, gid = wgid / nig, fm = gid * WGM, gsz = (nM - fm) < WGM ? (nM - fm) : WGM;
        u.pm = fm + ((wgid % nig) % gsz); u.pn = (wgid % nig) / gsz; return true;
    }
    __device__ __forceinline__ void a_ready(const Unit&) const {}
    __device__ __forceinline__ void done(const Unit&) const {}
};
__device__ __forceinline__ unsigned cvt_pk_bf16(float lo, float hi) { unsigned r; asm volatile("v_cvt_pk_bf16_f32 %0, %1, %2" : "=v"(r) : "v"(lo), "v"(hi)); return r; }

struct EpiF32 {
    static constexpr bool PERM = false;
    float* C; int ldc;
    __device__ __forceinline__ void operator()(const f32x4 (&acc)[2][2][4][2], const Unit& u, int wr, int wc, int fr, int fq) const {
        const int row0 = u.pm * BM + wr * 64 + fr, col0 = u.pn * BM + wc * 32 + 4 * fq;
#pragma unroll
        for (int ai = 0; ai < 2; ++ai)
#pragma unroll
            for (int m = 0; m < 4; ++m) { float* rowp = C + (size_t)(row0 + ai * HALF + m * 16) * ldc + col0;
#pragma unroll
                for (int bj = 0; bj < 2; ++bj)
#pragma unroll
                    for (int n = 0; n < 2; ++n) *(f32x4*)(rowp + bj * HALF + n * 16) = acc[ai][bj][m][n]; }
    }
};
struct EpiBf16 {
    static constexpr bool PERM = true;
    bf16_t* O; int ldc; int split_cols; size_t split_stride;
    __device__ __forceinline__ void operator()(const f32x4 (&acc)[2][2][4][2], const Unit& u, int wr, int wc, int fr, int fq) const {
        const int row0 = u.pm * BM + wr * 64 + fr; int colt = u.pn * BM; bf16_t* base = O;
        if (split_cols) { const int t = colt / split_cols; base += (size_t)t * split_stride; colt -= t * split_cols; }
        const int col0 = colt + wc * 32 + 8 * fq;
#pragma unroll
        for (int ai = 0; ai < 2; ++ai)
#pragma unroll
            for (int m = 0; m < 4; ++m) { bf16_t* rowp = base + (size_t)(row0 + ai * HALF + m * 16) * ldc + col0;
#pragma unroll
                for (int bj = 0; bj < 2; ++bj) { const f32x4 v0 = acc[ai][bj][m][0], v1 = acc[ai][bj][m][1];
                    u32x4 w; w.x = cvt_pk_bf16(v0[0], v0[1]); w.y = cvt_pk_bf16(v0[2], v0[3]); w.z = cvt_pk_bf16(v1[0], v1[1]); w.w = cvt_pk_bf16(v1[2], v1[3]);
                    *(u32x4*)(rowp + bj * HALF) = w; } }
    }
};
template <class Epi, class Sched>
__device__ __forceinline__ void gemm_phase(const Ctx& cx, LAS unsigned char* lds, const Gemm g, const Sched& S, const Epi& E) {
    const int tid = cx.tid, wid = __builtin_amdgcn_readfirstlane(tid >> 6), lane = tid & 63, wr = wid >> 2, wc = wid & 3, fr = lane & 15, fq = lane >> 4;
    const int K = g.K, nt = K / BK;
    unsigned voffA[2], voffB[2];
#pragma unroll
    for (int i = 0; i < 2; ++i) { int R, C; stage_rc(tid * 16 + i * 8192, R, C); const int Rb = Epi::PERM ? ((R & ~31) + perm32(R & 31)) : R;
        voffA[i] = (unsigned)(R * K + C) * 2u; voffB[i] = (unsigned)(Rb * K + C) * 2u; }
    const size_t kstep = (size_t)(BK * 2);
    const size_t hstep = (size_t)HALF * K * 2;
    const size_t tstep = 2 * hstep;
    const unsigned ldsw = (unsigned)wid * 1024u;
    const int aoff = lds_byte(wr * 64 + fr, fq * 8), boff = lds_byte(wc * 32 + fr, fq * 8);
#define PG8_SA(b, h) (((b) * 2 + (h)) * HTB)
#define PG8_SB(b, h) ((4 + (b) * 2 + (h)) * HTB)
#define PG8_STAGE(bufoff, gbase, voff) do { _Pragma("unroll") for (int _i = 0; _i < 2; ++_i) \
        __builtin_amdgcn_global_load_lds((const unsigned*)((const char*)(gbase) + (voff)[_i]), (LAS unsigned*)(lds + (bufoff) + ldsw + _i * 8192), 16, 0, 0); } while (0)
#define PG8_LDA(dst, b, h) do { _Pragma("unroll") for (int m = 0; m < 4; ++m) _Pragma("unroll") for (int k = 0; k < 2; ++k) dst[m][k] = *(const LAS bf16x8*)(lds + PG8_SA(b, h) + aoff + m * 2048 + k * 1024); } while (0)
#define PG8_LDB(dst, b, h) do { _Pragma("unroll") for (int n = 0; n < 2; ++n) _Pragma("unroll") for (int k = 0; k < 2; ++k) dst[n][k] = *(const LAS bf16x8*)(lds + PG8_SB(b, h) + boff + n * 2048 + k * 1024); } while (0)
#define PG8_MMA(ai, bj, At, Bt) do { __builtin_amdgcn_s_setprio(1); _Pragma("unroll") for (int m = 0; m < 4; ++m) _Pragma("unroll") for (int n = 0; n < 2; ++n) _Pragma("unroll") for (int k = 0; k < 2; ++k) \
        acc[ai][bj][m][n] = __builtin_amdgcn_mfma_f32_16x16x32_bf16(Bt[n][k], At[m][k], acc[ai][bj][m][n], 0, 0, 0); __builtin_amdgcn_s_setprio(0); } while (0)
#define PG8_WAIT_V(n) asm volatile("s_waitcnt vmcnt(" #n ")" ::: "memory")
#define PG8_WAIT_L(n) asm volatile("s_waitcnt lgkmcnt(" #n ")" ::: "memory")
#define PG8_BAR __builtin_amdgcn_s_barrier()
#define PG8_SCHED __builtin_amdgcn_sched_barrier(0)
    Unit cur, nxt; int ui = 0;
    if (!S.next(0, cur)) return;
    f32x4 acc[2][2][4][2];
#pragma unroll
    for (int a = 0; a < 2; ++a)
#pragma unroll
        for (int b = 0; b < 2; ++b)
#pragma unroll
            for (int m = 0; m < 4; ++m)
#pragma unroll
                for (int n = 0; n < 2; ++n) acc[a][b][m][n] = (f32x4){0.f, 0.f, 0.f, 0.f};
    bf16x8 At[4][2], B0[2][2], B1[2][2];
    const char* cA = (const char*)g.A + (size_t)cur.pm * tstep; const char* cB = (const char*)g.Bt + (size_t)cur.pn * tstep;
    S.a_ready(cur);
    PG8_STAGE(PG8_SB(0, 0), cB, voffB); PG8_STAGE(PG8_SA(0, 0), cA, voffA); PG8_STAGE(PG8_SB(0, 1), cB + hstep, voffB); PG8_STAGE(PG8_SA(0, 1), cA + hstep, voffA);
    if (wr == 1) PG8_BAR;
    PG8_WAIT_V(4); PG8_BAR;
    PG8_STAGE(PG8_SB(1, 0), cB + kstep, voffB); PG8_STAGE(PG8_SA(1, 0), cA + kstep, voffA); PG8_STAGE(PG8_SB(1, 1), cB + hstep + kstep, voffB);
    PG8_WAIT_V(6); PG8_BAR;
    for (;;) {
        const bool has_next = S.next(ui + 1, nxt);
        const char* nA = has_next ? (const char*)g.A + (size_t)nxt.pm * tstep : cA; const char* nB = has_next ? (const char*)g.Bt + (size_t)nxt.pn * tstep : cB;
        for (int t = 0; t < nt; t += 2) {
            const bool last = (t == nt - 2);
            const char* a1 = cA + (size_t)(t + 1) * kstep;
            const char* a2 = last ? nA : cA + (size_t)(t + 2) * kstep; const char* b2 = last ? nB : cB + (size_t)(t + 2) * kstep;
            const char* a3 = a2 + kstep; const char* b3 = b2 + kstep;
            if (last && has_next) S.a_ready(nxt);
            PG8_LDB(B0, 0, 0); PG8_SCHED; PG8_LDA(At, 0, 0); PG8_STAGE(PG8_SA(1, 1), a1 + hstep, voffA);
            PG8_WAIT_L(8); PG8_BAR; PG8_WAIT_L(0); PG8_MMA(0, 0, At, B0); PG8_BAR; PG8_SCHED;
            PG8_LDB(B1, 0, 1); PG8_STAGE(PG8_SB(0, 0), b2, voffB);
            PG8_BAR; PG8_WAIT_L(0); PG8_MMA(0, 1, At, B1); PG8_BAR;
            PG8_LDA(At, 0, 1); PG8_STAGE(PG8_SA(0, 0), a2, voffA);
            PG8_BAR; PG8_WAIT_L(0); PG8_MMA(1, 0, At, B0); PG8_BAR; PG8_SCHED;
            PG8_STAGE(PG8_SB(0, 1), b2 + hstep, voffB);
            PG8_WAIT_V(6); PG8_BAR; PG8_MMA(1, 1, At, B1); PG8_BAR;
            PG8_LDB(B0, 1, 0); PG8_SCHED; PG8_LDA(At, 1, 0); PG8_STAGE(PG8_SA(0, 1), a2 + hstep, voffA);
            PG8_WAIT_L(8); PG8_BAR; PG8_WAIT_L(0); PG8_MMA(0, 0, At, B0); PG8_BAR; PG8_SCHED;
            PG8_LDB(B1, 1, 1); PG8_STAGE(PG8_SB(1, 0), b3, voffB);
            PG8_BAR; PG8_WAIT_L(0); PG8_MMA(0, 1, At, B1); PG8_BAR;
            PG8_LDA(At, 1, 1); PG8_STAGE(PG8_SA(1, 0), a3, voffA);
            PG8_BAR; PG8_WAIT_L(0); PG8_MMA(1, 0, At, B0); PG8_BAR; PG8_SCHED;
            PG8_STAGE(PG8_SB(1, 1), b3 + hstep, voffB);
            PG8_WAIT_V(6); PG8_BAR; PG8_MMA(1, 1, At, B1); PG8_BAR;
        }
        E(acc, cur, wr, wc, fr, fq); S.done(cur);
        if (!has_next) break;
#pragma unroll
        for (int a = 0; a < 2; ++a)
#pragma unroll
            for (int b = 0; b < 2; ++b)
#pragma unroll
                for (int m = 0; m < 4; ++m)
#pragma unroll
                    for (int n = 0; n < 2; ++n) acc[a][b][m][n] = (f32x4){0.f, 0.f, 0.f, 0.f};
        cur = nxt; cA = nA; cB = nB; ++ui;
    }
    PG8_WAIT_V(0);
    if (wr == 0) PG8_BAR;
    PG8_BAR;
#undef PG8_SA
#undef PG8_SB
#undef PG8_STAGE
#undef PG8_LDA
#undef PG8_LDB
#undef PG8_MMA
#undef PG8_WAIT_V
#undef PG8_WAIT_L
#undef PG8_BAR
#undef PG8_SCHED
}
}

template <class Epi>
__device__ __forceinline__ void run_gemm(const Ctx& cx, unsigned char* smem, const bf16_t* A, const bf16_t* Bt, int M, int N, int K, const Epi& E) {
    pg8::Gemm g; g.A = A; g.Bt = Bt; g.M = M; g.N = N; g.K = K;
    pg8::StaticOrder S; S.init(M, N, (int)cx.nb, (int)cx.bid);
    pg8::gemm_phase<Epi, pg8::StaticOrder>(cx, (LAS unsigned char*)smem, g, S, E);
}

__device__ void p0_s5_setup(const Ctx& cx, PRM p, int u, unsigned char* smem) {
    const int l = u >> 8, g = (u >> 4) & 15, t = u & 15, tid = cx.tid;
    float* LP = (float*)smem;
    float* BB = LP + 2 * 17 * 64 * 2;
    float* CC = BB + 2 * 64 * 16 * 2;
    __syncthreads();
    for (int i = tid; i < 2 * 17 * 64; i += NTHR) {
        const int d = i / (17 * 64), n = (i / 64) % 17, pp = i & 63;
        const int gi = ((l * 2 + d) * 16 + g);
        const float dt = expf(p.s5_log_dt[gi]); const float ar = p.s5_a_re[gi * 64 + pp], ai = p.s5_a_im[gi * 64 + pp];
        const float mag = expf(ar * dt * (float)n); float sn, cs; sincosf(ai * dt * (float)n, &sn, &cs);
        LP[i * 2] = mag * cs; LP[i * 2 + 1] = mag * sn;
    }
    for (int i = tid; i < 2 * 16 * 64; i += NTHR) {
        const int d = i / 1024, hh = (i / 64) & 15, pp = i & 63;
        const size_t gi = ((size_t)(l * 2 + d) * 16 + g);
        CC[i * 2] = p.s5_c_re[(gi * 16 + hh) * 64 + pp]; CC[i * 2 + 1] = p.s5_c_im[(gi * 16 + hh) * 64 + pp];
    }
    __syncthreads();
    for (int i = tid; i < 2 * 64 * 16; i += NTHR) {
        const int d = i / 1024, pp = (i / 16) & 63, hh = i & 15;
        const int gi = ((l * 2 + d) * 16 + g);
        const float ar = p.s5_a_re[gi * 64 + pp], ai = p.s5_a_im[gi * 64 + pp];
        const float lr = LP[((d * 17 + 1) * 64 + pp) * 2], li = LP[((d * 17 + 1) * 64 + pp) * 2 + 1];
        const float den = ar * ar + ai * ai;
        const float zr = ((lr - 1.0f) * ar + li * ai) / den, zi = (li * ar - (lr - 1.0f) * ai) / den;
        const float br = p.s5_b_re[((size_t)gi * 64 + pp) * 16 + hh], bi = p.s5_b_im[((size_t)gi * 64 + pp) * 16 + hh];
        BB[i * 2] = zr * br - zi * bi; BB[i * 2 + 1] = zr * bi + zi * br;
    }
    __syncthreads();
    bf16_t* mc = p.McatT + ((size_t)(l * 16 + g) * 256 + t * 16) * 512;
    for (int e = tid; e < 16 * 512; e += NTHR) {
        const int hh = e >> 9, k = e & 511; float val = 0.f;
        if (k < 256) {
            const int s = k >> 4, h2 = k & 15;
#pragma unroll
            for (int d = 0; d < 2; ++d) {
                const bool on = d == 0 ? (t >= s) : (s >= t);
                if (on) { const int tau = d == 0 ? t - s : s - t; float acc = 0.f;
                    for (int pp = 0; pp < 64; ++pp) {
                        const float Lr = LP[((d * 17 + tau) * 64 + pp) * 2], Li = LP[((d * 17 + tau) * 64 + pp) * 2 + 1];
                        const float br = BB[((d * 64 + pp) * 16 + h2) * 2], bi = BB[((d * 64 + pp) * 16 + h2) * 2 + 1];
                        const float cr = CC[((d * 16 + hh) * 64 + pp) * 2], ci = CC[((d * 16 + hh) * 64 + pp) * 2 + 1];
                        const float wr = Lr * br - Li * bi, wi = Lr * bi + Li * br;
                        acc += cr * wr - ci * wi; }
                    val += acc; }
            }
        } else {
            const int kk = k - 256, d = kk >> 7, part = (kk >> 6) & 1, pp = kk & 63, npow = d == 0 ? t + 1 : 16 - t;
            const float Lr = LP[((d * 17 + npow) * 64 + pp) * 2], Li = LP[((d * 17 + npow) * 64 + pp) * 2 + 1];
            const float cr = CC[((d * 16 + hh) * 64 + pp) * 2], ci = CC[((d * 16 + hh) * 64 + pp) * 2 + 1];
            val = part == 0 ? (cr * Lr - ci * Li) : -(cr * Li + ci * Lr);
        }
        mc[(size_t)hh * 512 + k] = f2bf(val);
    }
    bf16_t* m2 = p.M2T + ((size_t)(l * 16 + g) * 256 + t * 16) * 256;
    for (int e = tid; e < 16 * 256; e += NTHR) {
        const int r = e >> 8, k = e & 255, n2 = t * 16 + r, d = n2 >> 7, part = (n2 >> 6) & 1, pp = n2 & 63, s = k >> 4, h2 = k & 15;
        const int ex = d == 0 ? 15 - s : s;
        const float Lr = LP[((d * 17 + ex) * 64 + pp) * 2], Li = LP[((d * 17 + ex) * 64 + pp) * 2 + 1];
        const float br = BB[((d * 64 + pp) * 16 + h2) * 2], bi = BB[((d * 64 + pp) * 16 + h2) * 2 + 1];
        m2[(size_t)r * 256 + k] = f2bf(part == 0 ? (Lr * br - Li * bi) : (Lr * bi + Li * br));
    }
    if (t == 0 && tid < 128) { const int d = tid >> 6, pp = tid & 63;
        float* o = p.L16 + ((size_t)((l * 2 + d) * 16 + g) * 64 + pp) * 2;
        o[0] = LP[((d * 17 + 16) * 64 + pp) * 2]; o[1] = LP[((d * 17 + 16) * 64 + pp) * 2 + 1]; }
}

__device__ void p0_mod(const Ctx& cx, PRM p, int u, unsigned char* smem) {
    const int l = u / 48, cb = u % 48, tid = cx.tid;
    float* sc = (float*)smem;
    float* red = sc + 5 * 1024;
    __syncthreads();
    for (int i = tid; i < 5 * 1024; i += NTHR) { const int r = i >> 10, k = i & 1023; const float v = r < 4 ? p.c[r * 1024 + k] : p.c_ctx[k]; sc[i] = siluf_(v); }
    __syncthreads();
    const int col = tid & 127, part = tid >> 7, j = cb * 128 + col;
    float a0 = 0.f, a1 = 0.f, a2 = 0.f, a3 = 0.f, a4 = 0.f;
    const float* w = p.w_ada + (size_t)l * 1024 * 6144 + j;
    for (int i = part * 256; i < part * 256 + 256; ++i) { const float wv = w[(size_t)i * 6144];
        a0 += sc[i] * wv; a1 += sc[1024 + i] * wv; a2 += sc[2048 + i] * wv; a3 += sc[3072 + i] * wv; a4 += sc[4096 + i] * wv; }
    red[(part * 5 + 0) * 128 + col] = a0; red[(part * 5 + 1) * 128 + col] = a1; red[(part * 5 + 2) * 128 + col] = a2; red[(part * 5 + 3) * 128 + col] = a3; red[(part * 5 + 4) * 128 + col] = a4;
    __syncthreads();
    for (int o = tid; o < 640; o += NTHR) { const int r = o >> 7, cc = o & 127, jj = cb * 128 + cc;
        const float s = red[(0 * 5 + r) * 128 + cc] + red[(1 * 5 + r) * 128 + cc] + red[(2 * 5 + r) * 128 + cc] + red[(3 * 5 + r) * 128 + cc];
        p.mod[((size_t)l * 5 + r) * 6144 + jj] = s + p.b_ada[l * 6144 + jj]; }
}

__device__ void p0_transpose(const Ctx& cx, const float* src, bf16_t* dst, int K, int N, int u, int nkt, unsigned char* smem) {
    const int nt_ = u / nkt, kt = u % nkt, tid = cx.tid;
    float* tile = (float*)smem;
    __syncthreads();
#pragma unroll
    for (int i = 0; i < 8; ++i) { const int r = (tid >> 6) + 8 * i, cc = tid & 63, n = nt_ * 64 + cc;
        tile[r * 65 + cc] = n < N ? src[(size_t)(kt * 64 + r) * N + n] : 0.f; }
    __syncthreads();
    const int cc = tid >> 3, r0 = (tid & 7) * 8;
    u32x4 w;
    w.x = pk2(tile[(r0 + 0) * 65 + cc], tile[(r0 + 1) * 65 + cc]); w.y = pk2(tile[(r0 + 2) * 65 + cc], tile[(r0 + 3) * 65 + cc]);
    w.z = pk2(tile[(r0 + 4) * 65 + cc], tile[(r0 + 5) * 65 + cc]); w.w = pk2(tile[(r0 + 6) * 65 + cc], tile[(r0 + 7) * 65 + cc]);
    *(u32x4*)(dst + (size_t)(nt_ * 64 + cc) * K + kt * 64 + r0) = w;
}

__device__ void phase0(const Ctx& cx, PRM p, unsigned char* smem) {
    constexpr int U_S5 = 512, U_MOD = 96, U_L = 3152, U_TOT = U_S5 + U_MOD + 2 * U_L;
    for (int u = cx.bid; u < U_TOT; u += cx.nb) {
        if (u < U_S5) p0_s5_setup(cx, p, u, smem);
        else if (u < U_S5 + U_MOD) p0_mod(cx, p, u - U_S5, smem);
        else {
            int v = u - U_S5 - U_MOD; const int l = v / U_L; v -= l * U_L;
            if (v < 768) p0_transpose(cx, p.w_in + (size_t)l * 1024 * DIN, p.WinT + (size_t)l * 3072 * 1024, 1024, DIN, v, 16, smem);
            else if (v < 1024) p0_transpose(cx, p.w_out + (size_t)l * 1024 * 1024, p.WoutT + (size_t)l * 1024 * 1024, 1024, 1024, v - 768, 16, smem);
            else if (v < 2432) p0_transpose(cx, p.w_up + (size_t)l * 1024 * 5632, p.WupT + (size_t)l * 5632 * 1024, 1024, 5632, v - 1024, 16, smem);
            else if (v < 3136) p0_transpose(cx, p.w_down + (size_t)l * DFF * 1024, p.WdownT + (size_t)l * 1024 * DFF, DFF, 1024, v - 2432, 44, smem);
            else p0_transpose(cx, p.s5_w_glu + (size_t)l * 256 * 256, p.WgluT + (size_t)l * 256 * 256, 256, 256, v - 3136, 4, smem);
        }
    }
}

__device__ __forceinline__ void ln_stats16(const float (&v)[16], float& mu, float& rstd) {
    float s = 0.f;
#pragma unroll
    for (int i = 0; i < 16; ++i) s += v[i];
    mu = wave_sum(s) * (1.0f / 1024.0f);
    float q = 0.f;
#pragma unroll
    for (int i = 0; i < 16; ++i) { const float d = v[i] - mu; q += d * d; }
    rstd = rsqrtf(wave_sum(q) * (1.0f / 1024.0f) + 1e-5f);
}
__device__ __forceinline__ void store_mod_bf16(bf16_t* dst, const float (&v)[16], const float* sh, const float* sc, int lane) {
    float mu, rstd; ln_stats16(v, mu, rstd);
#pragma unroll
    for (int i = 0; i < 4; ++i) { const int c0 = lane * 4 + 256 * i;
        const f32x4 s4 = *(const f32x4*)(sh + c0), c4 = *(const f32x4*)(sc + c0);
        float o[4];
#pragma unroll
        for (int j = 0; j < 4; ++j) o[j] = (v[i * 4 + j] - mu) * rstd * (1.0f + c4[j]) + s4[j];
        u32x2 w; w.x = pk2(o[0], o[1]); w.y = pk2(o[2], o[3]);
        *(u32x2*)(dst + c0) = w; }
}
__device__ void phase_ln_first(const Ctx& cx, PRM p) {
    const int wid = cx.tid >> 6, lane = cx.tid & 63;
    for (int row = cx.bid * 8 + wid; row < MROWS; row += cx.nb * 8) {
        const float* src = row < LROWS ? p.x + (size_t)row * 1024 : p.ctx + (size_t)(row - LROWS) * 1024;
        float v[16];
#pragma unroll
        for (int i = 0; i < 4; ++i) { const f32x4 t = *(const f32x4*)(src + lane * 4 + 256 * i); v[i * 4] = t[0]; v[i * 4 + 1] = t[1]; v[i * 4 + 2] = t[2]; v[i * 4 + 3] = t[3]; }
        const float* md = p.mod + (size_t)(0 * 5 + mod_row(row)) * 6144;
        store_mod_bf16(p.A1 + (size_t)row * 1024, v, md + 0 * 1024, md + 1 * 1024, lane);
    }
}
__device__ void phase_ln_res(const Ctx& cx, PRM p, int l, int which) {
    const int wid = cx.tid >> 6, lane = cx.tid & 63;
    const float* y = (const float*)(p.big + BIG_Y);
    const float* lg = (which == 0 ? p.ln1_g : p.ln2_g) + l * 1024; const float* lb = (which == 0 ? p.ln1_b : p.ln2_b) + l * 1024;
    const bool first_src = (l == 0 && which == 0);
    const bool want_a1 = !(l == 1 && which == 1);
    const int nrows = (l == 1) ? LROWS : MROWS;
    for (int row = cx.bid * 8 + wid; row < nrows; row += cx.nb * 8) {
        const float* hs; float* hd;
        if (row < LROWS) { hs = (first_src ? p.x : p.out) + (size_t)row * 1024; hd = p.out + (size_t)row * 1024; }
        else { hs = (first_src ? p.ctx : p.hc) + (size_t)(row - LROWS) * 1024; hd = p.hc + (size_t)(row - LROWS) * 1024; }
        const float* md = p.mod + (size_t)(l * 5 + mod_row(row)) * 6144;
        const float* gate = md + (which == 0 ? 2 : 5) * 1024;
        float v[16];
#pragma unroll
        for (int i = 0; i < 4; ++i) { const int c0 = lane * 4 + 256 * i;
            const f32x4 h4 = *(const f32x4*)(hs + c0), y4 = *(const f32x4*)(y + (size_t)row * 1024 + c0), g4 = *(const f32x4*)(gate + c0);
#pragma unroll
            for (int j = 0; j < 4; ++j) v[i * 4 + j] = ALPHA_C * h4[j] + g4[j] * y4[j]; }
        float mu, rstd; ln_stats16(v, mu, rstd);
#pragma unroll
        for (int i = 0; i < 4; ++i) { const int c0 = lane * 4 + 256 * i;
            const f32x4 g4 = *(const f32x4*)(lg + c0), b4 = *(const f32x4*)(lb + c0); f32x4 o;
#pragma unroll
            for (int j = 0; j < 4; ++j) { o[j] = (v[i * 4 + j] - mu) * rstd * g4[j] + b4[j]; v[i * 4 + j] = o[j]; }
            *(f32x4*)(hd + c0) = o; }
        if (want_a1) {
            const float* md2 = which == 0 ? md : p.mod + (size_t)((l + 1) * 5 + mod_row(row)) * 6144;
            const int si = which == 0 ? 3 : 0;
            store_mod_bf16(p.A1 + (size_t)row * 1024, v, md2 + si * 1024, md2 + (si + 1) * 1024, lane);
        }
    }
}

__device__ __forceinline__ int s5_rowbase(int q) { const int b = q / 528, j = q % 528; return j < 16 ? LROWS + b * 256 + j * 16 : b * 8192 + (j - 16) * 16; }

__device__ void phase_s5a(const Ctx& cx, PRM p, int l) {
    const int wid = cx.tid >> 6, lane = cx.tid & 63, fr = lane & 15, fq = lane >> 4;
    const bf16_t* z = (const bf16_t*)(p.big + BIG_Z);
    float* loc = (float*)(p.big + BIG_LOC);
    for (int job = cx.bid * 8 + wid; job < 16 * 132; job += cx.nb * 8) {
        const int g = job / 132, cgp = job % 132;
        const int rb = s5_rowbase(cgp * 16 + fr);
        bf16x8 a[8];
#pragma unroll
        for (int kk = 0; kk < 8; ++kk) a[kk] = *(const bf16x8*)(z + (size_t)(rb + kk * 2 + (fq >> 1)) * ZLD + ZC_U5 + g * 16 + (fq & 1) * 8);
        const bf16_t* m2 = p.M2T + (size_t)(l * 16 + g) * 256 * 256;
        for (int ntl = 0; ntl < 16; ++ntl) {
            f32x4 acc = {0.f, 0.f, 0.f, 0.f};
#pragma unroll
            for (int kk = 0; kk < 8; ++kk) { const bf16x8 b = *(const bf16x8*)(m2 + (size_t)(ntl * 16 + fr) * 256 + kk * 32 + fq * 8); acc = mfma16(a[kk], b, acc); }
            const int n2 = ntl * 16 + fr, d = n2 >> 7, n = n2 & 127;
#pragma unroll
            for (int jj = 0; jj < 4; ++jj) { const int q = cgp * 16 + fq * 4 + jj, b = q / 528, j = q % 528;
                loc[((size_t)((d * 4 + b) * 16 + g) * 528 + j) * 128 + n] = acc[jj]; }
        }
    }
}
__device__ void s5_carry(PRM p, int l, int chain, int lane) {
    const int d = chain >> 6, b = (chain >> 4) & 3, g = chain & 15;
    const float* loc = (const float*)(p.big + BIG_LOC) + (size_t)((d * 4 + b) * 16 + g) * 528 * 128;
    bf16_t* xe = (bf16_t*)(p.big + BIG_XE) + (size_t)(d * 4 + b) * 528 * 16 * 128 + (size_t)g * 128;
    const float* L = p.L16 + ((size_t)((l * 2 + d) * 16 + g) * 64 + lane) * 2;
    const float Lr = L[0], Li = L[1];
    float sr = 0.f, si = 0.f;
    for (int s0 = 0; s0 < 528; s0 += 8) {
        float vr[8], vi[8]; int js[8];
#pragma unroll
        for (int i = 0; i < 8; ++i) { const int s = s0 + i; const int j = d == 0 ? s : (s < 16 ? 15 - s : 543 - s); js[i] = j; vr[i] = loc[(size_t)j * 128 + lane]; vi[i] = loc[(size_t)j * 128 + 64 + lane]; }
#pragma unroll
        for (int i = 0; i < 8; ++i) {
            xe[(size_t)js[i] * 2048 + lane] = f2bf(sr); xe[(size_t)js[i] * 2048 + 64 + lane] = f2bf(si);
            const float nr = Lr * sr - Li * si + vr[i], ni = Lr * si + Li * sr + vi[i]; sr = nr; si = ni; }
    }
}
__device__ void phase_s5c(const Ctx& cx, PRM p, int l, int job) {
    const int lane = cx.tid & 63, fr = lane & 15, fq = lane >> 4;
    const bf16_t* z = (const bf16_t*)(p.big + BIG_Z);
    const bf16_t* xe = (const bf16_t*)(p.big + BIG_XE);
    bf16_t* g5 = (bf16_t*)(p.big + BIG_G5);
    const int g = job / 132, cgp = job % 132;
    const int qa = cgp * 16 + fr, rb = s5_rowbase(qa), ba = qa / 528, ja = qa % 528;
    bf16x8 a[16];
#pragma unroll
    for (int kk = 0; kk < 8; ++kk) a[kk] = *(const bf16x8*)(z + (size_t)(rb + kk * 2 + (fq >> 1)) * ZLD + ZC_U5 + g * 16 + (fq & 1) * 8);
#pragma unroll
    for (int kk = 0; kk < 8; ++kk) { const int d = kk >> 2; a[8 + kk] = *(const bf16x8*)(xe + ((size_t)((d * 4 + ba) * 528 + ja) * 16 + g) * 128 + (kk & 3) * 32 + fq * 8); }
    const bf16_t* mc = p.McatT + (size_t)(l * 16 + g) * 256 * 512;
    const float dsk = p.s5_d[l * 256 + g * 16 + fr];
    for (int t = 0; t < 16; ++t) {
        f32x4 acc = {0.f, 0.f, 0.f, 0.f};
#pragma unroll
        for (int kk = 0; kk < 16; ++kk) { const bf16x8 b = *(const bf16x8*)(mc + (size_t)(t * 16 + fr) * 512 + kk * 32 + fq * 8); acc = mfma16(a[kk], b, acc); }
#pragma unroll
        for (int jj = 0; jj < 4; ++jj) { const int q = cgp * 16 + fq * 4 + jj; const int row = s5_rowbase(q) + t;
            const float u = bf2f(z[(size_t)row * ZLD + ZC_U5 + g * 16 + fr]);
            g5[(size_t)row * 256 + g * 16 + fr] = f2bf(gelu_tanh(acc[jj] + dsk * u)); }
    }
}

__device__ __forceinline__ int walk_rowbase(int b, int d, int s) {
    if (d == 0) return s < 4 ? LROWS + b * 256 + s * 64 : b * 8192 + (s - 4) * 64;
    return s < 4 ? LROWS + b * 256 + (3 - s) * 64 : b * 8192 + (131 - s) * 64;
}
constexpr int HALF_LDS = 75 * 1024;

__device__ void mlstm_walk(PRM p, int l, int job, unsigned char* hl, int tid) {
    const int chain = job / 3, slice = job % 3, d = chain >> 4, b = (chain >> 2) & 3, h = chain & 3;
    const int wv = tid >> 6, lane = tid & 63, fr = lane & 15, fq = lane >> 4;
    bf16_t* Q = (bf16_t*)hl;
    bf16_t* Kk = Q + 64 * 104;
    bf16_t* KT = Kk + 64 * 104;
    bf16_t* VT = KT + 96 * 72;
    bf16_t* VTW = VT + 32 * 72;
    bf16_t* P = VTW + 32 * 72;
    bf16_t* CT = P + 64 * 72;
    float* fa = (float*)(CT + 2 * 32 * 104);
    float* A_T = fa; float* C_S = fa + 64; float* W_S = fa + 128; float* WI = fa + 192; float* EM = fa + 256; float* DI = fa + 320; float* QN = fa + 384; float* NE = fa + 448; float* SC = fa + 544;
    const bf16_t* z = (const bf16_t*)(p.big + BIG_Z);
    bf16_t* ob = (bf16_t*)(p.big + BIG_OBUF) + (size_t)d * MROWS * 768;
    const float ib = p.ml_i_bias[(l * 2 + d) * 4 + h], fb = p.ml_f_bias[(l * 2 + d) * 4 + h];
    f32x4 cacc[3];
#pragma unroll
    for (int i = 0; i < 3; ++i) cacc[i] = (f32x4){0.f, 0.f, 0.f, 0.f};
    for (int i = tid; i < 2 * 32 * 104; i += 256) CT[i] = 0;
    if (tid < 96) NE[tid] = 0.f;
    float m_state = 0.f;
    const int vt_s = wv & 1, kt0 = (wv >> 1) * 3;
    for (int s = 0; s < 132; ++s) {
        const int rbase = walk_rowbase(b, d, s);
        bf16_t* CTc = CT + (s & 1) * 32 * 104; bf16_t* CTn = CT + ((s + 1) & 1) * 32 * 104;
        __syncthreads();
        for (int i = tid; i < 768; i += 256) { const int r = i / 12, c8 = i % 12; const int row = rbase + (d ? 63 - r : r);
            *(u32x4*)(Q + r * 104 + c8 * 8) = *(const u32x4*)(z + (size_t)row * ZLD + ZC_MQ + h * 96 + c8 * 8);
            const u32x4 kv = *(const u32x4*)(z + (size_t)row * ZLD + ZC_MK + h * 96 + c8 * 8);
            const float ksc = 0.10206207261f;
            u32x4 ks; ks.x = pk2(lo2f(kv.x) * ksc, hi2f(kv.x) * ksc); ks.y = pk2(lo2f(kv.y) * ksc, hi2f(kv.y) * ksc); ks.z = pk2(lo2f(kv.z) * ksc, hi2f(kv.z) * ksc); ks.w = pk2(lo2f(kv.w) * ksc, hi2f(kv.w) * ksc);
            *(u32x4*)(Kk + r * 104 + c8 * 8) = ks;
            bf16_t* kt = KT + (c8 * 8) * 72 + r;
            kt[0 * 72] = (bf16_t)(ks.x & 0xFFFF); kt[1 * 72] = (bf16_t)(ks.x >> 16); kt[2 * 72] = (bf16_t)(ks.y & 0xFFFF); kt[3 * 72] = (bf16_t)(ks.y >> 16);
            kt[4 * 72] = (bf16_t)(ks.z & 0xFFFF); kt[5 * 72] = (bf16_t)(ks.z >> 16); kt[6 * 72] = (bf16_t)(ks.w & 0xFFFF); kt[7 * 72] = (bf16_t)(ks.w >> 16); }
        { const int r = tid >> 2, c8 = tid & 3; const int row = rbase + (d ? 63 - r : r);
            const u32x4 vv = *(const u32x4*)(z + (size_t)row * ZLD + ZC_MV + h * 96 + slice * 32 + c8 * 8);
            bf16_t* vt = VT + (c8 * 8) * 72 + r;
            vt[0 * 72] = (bf16_t)(vv.x & 0xFFFF); vt[1 * 72] = (bf16_t)(vv.x >> 16); vt[2 * 72] = (bf16_t)(vv.y & 0xFFFF); vt[3 * 72] = (bf16_t)(vv.y >> 16);
            vt[4 * 72] = (bf16_t)(vv.z & 0xFFFF); vt[5 * 72] = (bf16_t)(vv.z >> 16); vt[6 * 72] = (bf16_t)(vv.w & 0xFFFF); vt[7 * 72] = (bf16_t)(vv.w >> 16); }
        float m_new = 0.f, alpha = 0.f;
        if (wv == 0) {
            const int row = rbase + (d ? 63 - lane : lane);
            const float ig = bf2f(z[(size_t)row * ZLD + ZC_MIG + d * 4 + h]) + ib;
            const float lf = logsigmoidf_(bf2f(z[(size_t)row * ZLD + ZC_MFG + d * 4 + h]) + fb);
            float F = lf;
#pragma unroll
            for (int o = 1; o < 64; o <<= 1) { const float t = __shfl_up(F, o, 64); if (lane >= o) F += t; }
            const float F_last = __shfl(F, 63, 64);
            const float gg = F_last - F + ig;
            const float m_loc = wave_max(gg);
            const float cs = ig - F;
            float pm = cs;
#pragma unroll
            for (int o = 1; o < 64; o <<= 1) { const float t = __shfl_up(pm, o, 64); if (lane >= o) pm = fmaxf(pm, t); }
            const float inter = F + m_state;
            const float m_t = fmaxf(inter, F + pm);
            m_new = fmaxf(F_last + m_state, m_loc);
            alpha = __expf(F_last + m_state - m_new);
            const float beta = __expf(m_loc - m_new);
            A_T[lane] = F - m_t; C_S[lane] = cs; W_S[lane] = beta * __expf(gg - m_loc); WI[lane] = __expf(inter - m_t); EM[lane] = __expf(-m_t);
            if (lane == 0) { SC[0] = alpha; SC[1] = m_new; }
        }
        __syncthreads();
        alpha = SC[0]; m_new = SC[1];
        {
            f32x4 acc[4];
#pragma unroll
            for (int st = 0; st < 4; ++st) acc[st] = (f32x4){0.f, 0.f, 0.f, 0.f};
#pragma unroll
            for (int kk = 0; kk < 3; ++kk) { const bf16x8 a = *(const bf16x8*)(Q + (wv * 16 + fr) * 104 + kk * 32 + fq * 8);
#pragma unroll
                for (int st = 0; st < 4; ++st) if (st <= wv) { const bf16x8 bb = *(const bf16x8*)(Kk + (st * 16 + fr) * 104 + kk * 32 + fq * 8); acc[st] = mfma16(a, bb, acc[st]); } }
            float rs[4] = {0.f, 0.f, 0.f, 0.f};
#pragma unroll
            for (int st = 0; st < 4; ++st) { const int sidx = st * 16 + fr; const float cs = C_S[sidx];
#pragma unroll
                for (int jj = 0; jj < 4; ++jj) { const int t = wv * 16 + fq * 4 + jj;
                    float pv = 0.f; if (st <= wv && sidx <= t) pv = __expf(A_T[t] + cs) * acc[st][jj];
                    rs[jj] += pv; P[t * 72 + sidx] = f2bf(pv); } }
#pragma unroll
            for (int jj = 0; jj < 4; ++jj) { float v = rs[jj]; v += __shfl_xor(v, 1, 64); v += __shfl_xor(v, 2, 64); v += __shfl_xor(v, 4, 64); v += __shfl_xor(v, 8, 64); if (fr == 0) DI[wv * 16 + fq * 4 + jj] = v; }
        }
        {
            const int vr = tid >> 3, s8 = (tid & 7) * 8; const u32x4 vv = *(const u32x4*)(VT + vr * 72 + s8); u32x4 o;
            o.x = pk2(lo2f(vv.x) * W_S[s8 + 0], hi2f(vv.x) * W_S[s8 + 1]); o.y = pk2(lo2f(vv.y) * W_S[s8 + 2], hi2f(vv.y) * W_S[s8 + 3]);
            o.z = pk2(lo2f(vv.z) * W_S[s8 + 4], hi2f(vv.z) * W_S[s8 + 5]); o.w = pk2(lo2f(vv.w) * W_S[s8 + 6], hi2f(vv.w) * W_S[s8 + 7]);
            *(u32x4*)(VTW + vr * 72 + s8) = o; }
        {
            const int t = tid >> 2, part = tid & 3; float sacc = 0.f;
#pragma unroll
            for (int k = 0; k < 24; ++k) sacc += bf2f(Q[t * 104 + part * 24 + k]) * NE[part * 24 + k];
            sacc += __shfl_xor(sacc, 1, 64); sacc += __shfl_xor(sacc, 2, 64);
            if (part == 0) QN[t] = sacc; }
        __syncthreads();
        {
            f32x4 a1[2], a2[2];
#pragma unroll
            for (int vt = 0; vt < 2; ++vt) { a1[vt] = (f32x4){0.f, 0.f, 0.f, 0.f}; a2[vt] = (f32x4){0.f, 0.f, 0.f, 0.f}; }
#pragma unroll
            for (int kk = 0; kk < 3; ++kk) { const bf16x8 a = *(const bf16x8*)(Q + (wv * 16 + fr) * 104 + kk * 32 + fq * 8);
#pragma unroll
                for (int vt = 0; vt < 2; ++vt) { const bf16x8 bb = *(const bf16x8*)(CTc + (vt * 16 + fr) * 104 + kk * 32 + fq * 8); a1[vt] = mfma16(a, bb, a1[vt]); } }
#pragma unroll
            for (int kk = 0; kk < 2; ++kk) { const bf16x8 a = *(const bf16x8*)(P + (wv * 16 + fr) * 72 + kk * 32 + fq * 8);
#pragma unroll
                for (int vt = 0; vt < 2; ++vt) { const bf16x8 bb = *(const bf16x8*)(VT + (vt * 16 + fr) * 72 + kk * 32 + fq * 8); a2[vt] = mfma16(a, bb, a2[vt]); } }
#pragma unroll
            for (int jj = 0; jj < 4; ++jj) { const int t = wv * 16 + fq * 4 + jj; const float wi = WI[t];
                const float den = wi * QN[t] + DI[t]; const float dn = fmaxf(fabsf(den), EM[t]); const float inv = 1.0f / dn;
                const int row = rbase + (d ? 63 - t : t);
#pragma unroll
                for (int vt = 0; vt < 2; ++vt) ob[(size_t)row * 768 + 384 + h * 96 + slice * 32 + vt * 16 + fr] = f2bf((wi * a1[vt][jj] + a2[vt][jj]) * inv); }
        }
        {
#pragma unroll
            for (int i = 0; i < 3; ++i) { cacc[i] *= alpha;
#pragma unroll
                for (int kk = 0; kk < 2; ++kk) { const bf16x8 a = *(const bf16x8*)(VTW + (vt_s * 16 + fr) * 72 + kk * 32 + fq * 8);
                    const bf16x8 bb = *(const bf16x8*)(KT + ((kt0 + i) * 16 + fr) * 72 + kk * 32 + fq * 8); cacc[i] = mfma16(a, bb, cacc[i]); }
#pragma unroll
                for (int jj = 0; jj < 4; ++jj) CTn[(vt_s * 16 + fq * 4 + jj) * 104 + (kt0 + i) * 16 + fr] = f2bf(cacc[i][jj]); }
            if (tid < 96) { float nk = alpha * NE[tid];
                for (int ss = 0; ss < 64; ++ss) nk += W_S[ss] * bf2f(Kk[ss * 104 + tid]);
                NE[tid] = nk; }
            m_state = m_new;
        }
    }
}

__device__ void gla_walk(PRM p, int l, int job, unsigned char* hl, int tid) {
    const int chain = job / 3, slice = job % 3, d = chain >> 4, b = (chain >> 2) & 3, h = chain & 3;
    const int wv = tid >> 6, lane = tid & 63, fr = lane & 15, fq = lane >> 4;
    bf16_t* QD = (bf16_t*)hl;
    bf16_t* KD = QD + 64 * 72;
    bf16_t* ATT = KD + 64 * 72;
    bf16_t* KDLT = ATT + 64 * 72;
    bf16_t* VT = KDLT + 48 * 72;
    bf16_t* ST = VT + 32 * 72;
    float* LG = (float*)(ST + 2 * 32 * 72);
    float* BL = LG + 64 * 49;
    float* WA = BL + 48;
    float* BA = WA + 16 * 48;
    const bf16_t* z = (const bf16_t*)(p.big + BIG_Z);
    bf16_t* ob = (bf16_t*)(p.big + BIG_OBUF) + (size_t)d * MROWS * 768;
    for (int i = tid; i < 3 * 64 * 72; i += 256) QD[i] = 0;
    for (int i = tid; i < 2 * 32 * 72; i += 256) ST[i] = 0;
    for (int i = tid; i < 16 * 48; i += 256) WA[i] = p.gla_w_a2[((size_t)(l * 2 + d) * 16 + i / 48) * 192 + h * 48 + i % 48];
    if (tid < 48) BA[tid] = p.gla_b_a[(l * 2 + d) * 192 + h * 48 + tid];
    f32x4 sacc[2];
    sacc[0] = (f32x4){0.f, 0.f, 0.f, 0.f}; sacc[1] = (f32x4){0.f, 0.f, 0.f, 0.f};
    const int vt_s = wv & 1, kt0 = (wv >> 1) * 2, nkt = (wv >> 1) == 0 ? 2 : 1;
    for (int s = 0; s < 132; ++s) {
        const int rbase = walk_rowbase(b, d, s);
        bf16_t* STc = ST + (s & 1) * 32 * 72; bf16_t* STn = ST + ((s + 1) & 1) * 32 * 72;
        __syncthreads();
        for (int i = tid; i < 384; i += 256) { const int r = i / 6, c8 = i % 6; const int row = rbase + (d ? 63 - r : r);
            const u32x4 qv = *(const u32x4*)(z + (size_t)row * ZLD + ZC_GQ + h * 48 + c8 * 8);
            const float qs = 0.14433756729f;
            u32x4 q2; q2.x = pk2(lo2f(qv.x) * qs, hi2f(qv.x) * qs); q2.y = pk2(lo2f(qv.y) * qs, hi2f(qv.y) * qs); q2.z = pk2(lo2f(qv.z) * qs, hi2f(qv.z) * qs); q2.w = pk2(lo2f(qv.w) * qs, hi2f(qv.w) * qs);
            *(u32x4*)(QD + r * 72 + c8 * 8) = q2;
            *(u32x4*)(KD + r * 72 + c8 * 8) = *(const u32x4*)(z + (size_t)row * ZLD + ZC_GK + h * 48 + c8 * 8); }
        { const int r = tid >> 2, c8 = tid & 3; const int row = rbase + (d ? 63 - r : r);
            const u32x4 vv = *(const u32x4*)(z + (size_t)row * ZLD + ZC_GV + h * 96 + slice * 32 + c8 * 8);
            bf16_t* vt = VT + (c8 * 8) * 72 + r;
            vt[0 * 72] = (bf16_t)(vv.x & 0xFFFF); vt[1 * 72] = (bf16_t)(vv.x >> 16); vt[2 * 72] = (bf16_t)(vv.y & 0xFFFF); vt[3 * 72] = (bf16_t)(vv.y >> 16);
            vt[4 * 72] = (bf16_t)(vv.z & 0xFFFF); vt[5 * 72] = (bf16_t)(vv.z >> 16); vt[6 * 72] = (bf16_t)(vv.w & 0xFFFF); vt[7 * 72] = (bf16_t)(vv.w >> 16);
            const u32x4 l0 = *(const u32x4*)(z + (size_t)row * ZLD + ZC_GLR + d * 16), l1 = *(const u32x4*)(z + (size_t)row * ZLD + ZC_GLR + d * 16 + 8);
            float lr[16];
            lr[0] = lo2f(l0.x); lr[1] = hi2f(l0.x); lr[2] = lo2f(l0.y); lr[3] = hi2f(l0.y); lr[4] = lo2f(l0.z); lr[5] = hi2f(l0.z); lr[6] = lo2f(l0.w); lr[7] = hi2f(l0.w);
            lr[8] = lo2f(l1.x); lr[9] = hi2f(l1.x); lr[10] = lo2f(l1.y); lr[11] = hi2f(l1.y); lr[12] = lo2f(l1.z); lr[13] = hi2f(l1.z); lr[14] = lo2f(l1.w); lr[15] = hi2f(l1.w);
            for (int kq = 0; kq < 12; ++kq) { const int k = c8 * 12 + kq; float zz = BA[k];
#pragma unroll
                for (int rr = 0; rr < 16; ++rr) zz += lr[rr] * WA[rr * 48 + k];
                LG[r * 49 + k] = logsigmoidf_(zz) * (1.0f / 16.0f); } }
        __syncthreads();
        if (tid < 48) { float run = 0.f;
#pragma unroll 8
            for (int ss = 0; ss < 64; ++ss) { run += LG[ss * 49 + tid]; LG[ss * 49 + tid] = run; }
            BL[tid] = run; }
        __syncthreads();
        { const int r = tid >> 2, c8 = tid & 3;
            for (int kq = 0; kq < 12; ++kq) { const int k = c8 * 12 + kq; const float bq = LG[r * 49 + k]; const float q = bf2f(QD[r * 72 + k]), kx = bf2f(KD[r * 72 + k]);
                QD[r * 72 + k] = f2bf(q * __expf(bq)); KD[r * 72 + k] = f2bf(kx * __expf(-bq)); KDLT[k * 72 + r] = f2bf(kx * __expf(BL[k] - bq)); } }
        __syncthreads();
        {
            f32x4 acc[4];
#pragma unroll
            for (int st = 0; st < 4; ++st) acc[st] = (f32x4){0.f, 0.f, 0.f, 0.f};
#pragma unroll
            for (int kk = 0; kk < 2; ++kk) { const bf16x8 a = *(const bf16x8*)(QD + (wv * 16 + fr) * 72 + kk * 32 + fq * 8);
#pragma unroll
                for (int st = 0; st < 4; ++st) if (st <= wv) { const bf16x8 bb = *(const bf16x8*)(KD + (st * 16 + fr) * 72 + kk * 32 + fq * 8); acc[st] = mfma16(a, bb, acc[st]); } }
#pragma unroll
            for (int st = 0; st < 4; ++st) { const int sidx = st * 16 + fr;
#pragma unroll
                for (int jj = 0; jj < 4; ++jj) { const int t = wv * 16 + fq * 4 + jj; const float pv = (st <= wv && sidx <= t) ? acc[st][jj] : 0.f; ATT[t * 72 + sidx] = f2bf(pv); } }
        }
        __syncthreads();
        {
            f32x4 a1[2];
#pragma unroll
            for (int vt = 0; vt < 2; ++vt) a1[vt] = (f32x4){0.f, 0.f, 0.f, 0.f};
#pragma unroll
            for (int kk = 0; kk < 2; ++kk) { const bf16x8 a = *(const bf16x8*)(QD + (wv * 16 + fr) * 72 + kk * 32 + fq * 8);
                const bf16x8 a2 = *(const bf16x8*)(ATT + (wv * 16 + fr) * 72 + kk * 32 + fq * 8);
#pragma unroll
                for (int vt = 0; vt < 2; ++vt) { const bf16x8 bb = *(const bf16x8*)(STc + (vt * 16 + fr) * 72 + kk * 32 + fq * 8); a1[vt] = mfma16(a, bb, a1[vt]);
                    const bf16x8 b2 = *(const bf16x8*)(VT + (vt * 16 + fr) * 72 + kk * 32 + fq * 8); a1[vt] = mfma16(a2, b2, a1[vt]); } }
#pragma unroll
            for (int jj = 0; jj < 4; ++jj) { const int t = wv * 16 + fq * 4 + jj; const int row = rbase + (d ? 63 - t : t);
#pragma unroll
                for (int vt = 0; vt < 2; ++vt) ob[(size_t)row * 768 + h * 96 + slice * 32 + vt * 16 + fr] = f2bf(a1[vt][jj]); }
        }
#pragma unroll
        for (int i = 0; i < 2; ++i) if (i < nkt) { const int kt = kt0 + i; const float dec = __expf(BL[kt * 16 + fr]); sacc[i] *= dec;
#pragma unroll
            for (int kk = 0; kk < 2; ++kk) { const bf16x8 a = *(const bf16x8*)(VT + (vt_s * 16 + fr) * 72 + kk * 32 + fq * 8);
                const bf16x8 bb = *(const bf16x8*)(KDLT + (kt * 16 + fr) * 72 + kk * 32 + fq * 8); sacc[i] = mfma16(a, bb, sacc[i]); }
#pragma unroll
            for (int jj = 0; jj < 4; ++jj) STn[(vt_s * 16 + fq * 4 + jj) * 72 + kt * 16 + fr] = f2bf(sacc[i][jj]); }
    }
}

__device__ void phase_walks(const Ctx& cx, PRM p, int l, unsigned char* smem) {
    const int blk = cx.bid, tid = cx.tid, half = tid >> 8;
    if (blk < 48) gla_walk(p, l, blk * 2 + half, smem + half * HALF_LDS, tid & 255);
    else if (blk < 96) mlstm_walk(p, l, (blk - 48) * 2 + half, smem + half * HALF_LDS, tid & 255);
    else { const int w = (blk - 96) * 8 + (tid >> 6); if (w < 128) s5_carry(p, l, w, tid & 63); }
}

__device__ void post_row(PRM p, int l, int row, int lane) {
    const bf16_t* z = (const bf16_t*)(p.big + BIG_Z);
    const bf16_t* of = (const bf16_t*)(p.big + BIG_OBUF) + (size_t)row * 768 + lane * 12;
    const bf16_t* obk = of + (size_t)MROWS * 768;
    float v[12];
#pragma unroll
    for (int i = 0; i < 3; ++i) { const u32x2 a = *(const u32x2*)(of + i * 4), b = *(const u32x2*)(obk + i * 4);
        v[i * 4 + 0] = lo2f(a.x) + lo2f(b.x); v[i * 4 + 1] = hi2f(a.x) + hi2f(b.x); v[i * 4 + 2] = lo2f(a.y) + lo2f(b.y); v[i * 4 + 3] = hi2f(a.y) + hi2f(b.y); }
    float s = 0.f;
#pragma unroll
    for (int i = 0; i < 12; ++i) s += v[i];
    s += __shfl_xor(s, 1, 64); s += __shfl_xor(s, 2, 64); s += __shfl_xor(s, 4, 64);
    const float mu = s * (1.0f / 96.0f);
    float q = 0.f;
#pragma unroll
    for (int i = 0; i < 12; ++i) { const float dd = v[i] - mu; q += dd * dd; }
    q += __shfl_xor(q, 1, 64); q += __shfl_xor(q, 2, 64); q += __shfl_xor(q, 4, 64);
    const float rstd = rsqrtf(q * (1.0f / 96.0f) + 1e-5f);
    const bool isml = lane >= 32;
    const int c0 = (lane & 31) * 12;
    const float* gw = (isml ? p.ml_g : p.gla_g) + l * 384 + c0;
    const bf16_t* gt = z + (size_t)row * ZLD + (isml ? ZC_MO : ZC_GR) + c0;
    bf16_t* dst = p.A1 + (size_t)row * 1024 + 256 + lane * 12;
#pragma unroll
    for (int i = 0; i < 3; ++i) { const u32x2 gv = *(const u32x2*)(gt + i * 4);
        float gg[4] = {lo2f(gv.x), hi2f(gv.x), lo2f(gv.y), hi2f(gv.y)}; float o[4];
#pragma unroll
        for (int j = 0; j < 4; ++j) { const float gate = isml ? sigmoidf_(gg[j]) : siluf_(gg[j]); o[j] = gate * ((v[i * 4 + j] - mu) * rstd * gw[i * 4 + j]); }
        u32x2 w; w.x = pk2(o[0], o[1]); w.y = pk2(o[2], o[3]); *(u32x2*)(dst + i * 4) = w; }
}
__device__ void phase_s5c_post(const Ctx& cx, PRM p, int l) {
    const int wid = cx.tid >> 6, lane = cx.tid & 63;
    const int nw = cx.nb * 8;
    for (int job = cx.bid * 8 + wid; job < 16 * 132; job += nw) phase_s5c(cx, p, l, job);
    for (int row = cx.bid * 8 + wid; row < MROWS; row += nw) post_row(p, l, row, lane);
}


__device__ void phase_glu(const Ctx& cx, PRM p, int l) {
    const int wid = cx.tid >> 6, lane = cx.tid & 63, fr = lane & 15, fq = lane >> 4;
    const bf16_t* g5 = (const bf16_t*)(p.big + BIG_G5);
    const bf16_t* wg = p.WgluT + (size_t)l * 256 * 256;
    const float* bias = p.s5_b_glu + l * 256;
    bf16_t* A1 = p.A1;
    for (int job = cx.bid * 8 + wid; job < MROWS / 16; job += cx.nb * 8) {
        const int r0 = job * 16;
        bf16x8 a[8];
#pragma unroll
        for (int kk = 0; kk < 8; ++kk) a[kk] = *(const bf16x8*)(g5 + (size_t)(r0 + fr) * 256 + kk * 32 + fq * 8);
        for (int ntl = 0; ntl < 16; ++ntl) {
            f32x4 acc = {0.f, 0.f, 0.f, 0.f};
#pragma unroll
            for (int kk = 0; kk < 8; ++kk) { const bf16x8 b = *(const bf16x8*)(wg + (size_t)(ntl * 16 + fr) * 256 + kk * 32 + fq * 8); acc = mfma16(a[kk], b, acc); }
            const int col = ntl * 16 + fr; const float bs = bias[col];
#pragma unroll
            for (int jj = 0; jj < 4; ++jj) { const int row = r0 + fq * 4 + jj; const float y = bf2f(g5[(size_t)row * 256 + col]);
                A1[(size_t)row * 1024 + col] = f2bf(y * sigmoidf_(acc[jj] + bs)); }
        }
    }
}

__device__ void phase_conv(const Ctx& cx, PRM p, int l) {
    const bf16_t* a = (const bf16_t*)(p.big + BIG_A);
    bf16_t* vg = (bf16_t*)(p.big + BIG_V);
    const float* wd = p.w_dconv + (size_t)l * 9 * DFF; const float* bd = p.b_dconv + (size_t)l * DFF;
    const long total = (long)MROWS * 352;
    for (long it = (long)cx.bid * NTHR + cx.tid; it < total; it += (long)cx.nb * NTHR) {
        const int row = (int)(it / 352), c0 = (int)(it % 352) * 8;
        int y, x, H, W, base;
        if (row < LROWS) { const int t = row & 8191; base = row - t; y = t >> 6; x = t & 63; H = 128; W = 64; }
        else { const int t = (row - LROWS) & 255; base = row - t; y = 0; x = t; H = 1; W = 256; }
        float acc[8];
        { const f32x4 b0 = *(const f32x4*)(bd + c0), b1 = *(const f32x4*)(bd + c0 + 4); acc[0] = b0[0]; acc[1] = b0[1]; acc[2] = b0[2]; acc[3] = b0[3]; acc[4] = b1[0]; acc[5] = b1[1]; acc[6] = b1[2]; acc[7] = b1[3]; }
#pragma unroll
        for (int dy = -1; dy <= 1; ++dy) {
            const int yy = y + dy; if (yy < 0 || yy >= H) continue;
#pragma unroll
            for (int dx = -1; dx <= 1; ++dx) {
                const int xx = x + dx; if (xx < 0 || xx >= W) continue;
                const u32x4 av = *(const u32x4*)(a + (size_t)(base + yy * W + xx) * DFF + c0);
                const float* wp = wd + ((dy + 1) * 3 + (dx + 1)) * DFF + c0;
                const f32x4 w0 = *(const f32x4*)wp, w1 = *(const f32x4*)(wp + 4);
                acc[0] += lo2f(av.x) * w0[0]; acc[1] += hi2f(av.x) * w0[1]; acc[2] += lo2f(av.y) * w0[2]; acc[3] += hi2f(av.y) * w0[3];
                acc[4] += lo2f(av.z) * w1[0]; acc[5] += hi2f(av.z) * w1[1]; acc[6] += lo2f(av.w) * w1[2]; acc[7] += hi2f(av.w) * w1[3];
            }
        }
        const u32x4 vv = *(const u32x4*)(vg + (size_t)row * DFF + c0);
        u32x4 o;
        o.x = pk2(gelu_tanh(acc[0]) * lo2f(vv.x), gelu_tanh(acc[1]) * hi2f(vv.x)); o.y = pk2(gelu_tanh(acc[2]) * lo2f(vv.y), gelu_tanh(acc[3]) * hi2f(vv.y));
        o.z = pk2(gelu_tanh(acc[4]) * lo2f(vv.z), gelu_tanh(acc[5]) * hi2f(vv.z)); o.w = pk2(gelu_tanh(acc[6]) * lo2f(vv.w), gelu_tanh(acc[7]) * hi2f(vv.w));
        *(u32x4*)(vg + (size_t)row * DFF + c0) = o;
    }
}

__device__ void run_phase(const Ctx& cx, PRM p, int ph, unsigned char* smem) {
    if (ph == 0) { phase0(cx, p, smem); return; }
    const int l = (ph - 1) / 12, q = (ph - 1) % 12;
    switch (q) {
        case 0: if (l == 0) phase_ln_first(cx, p); break;
        case 1: { pg8::EpiBf16 E; E.O = (bf16_t*)(p.big + BIG_Z); E.ldc = ZLD; E.split_cols = 0; E.split_stride = 0;
            run_gemm(cx, smem, p.A1, p.WinT + (size_t)l * 3072 * 1024, MROWS, 3072, 1024, E); } break;
        case 2: phase_s5a(cx, p, l); break;
        case 3: phase_walks(cx, p, l, smem); break;
        case 4: phase_s5c_post(cx, p, l); break;
        case 5: phase_glu(cx, p, l); break;
        case 6: { pg8::EpiF32 E; E.C = (float*)(p.big + BIG_Y); E.ldc = 1024;
            run_gemm(cx, smem, p.A1, p.WoutT + (size_t)l * 1024 * 1024, l == 1 ? LROWS : MROWS, 1024, 1024, E); } break;
        case 7: phase_ln_res(cx, p, l, 0); break;
        case 8: { pg8::EpiBf16 E; E.O = (bf16_t*)(p.big + BIG_A); E.ldc = DFF; E.split_cols = DFF; E.split_stride = (size_t)MROWS * DFF;
            run_gemm(cx, smem, p.A1, p.WupT + (size_t)l * 5632 * 1024, MROWS, 5632, 1024, E); } break;
        case 9: phase_conv(cx, p, l); break;
        case 10: { pg8::EpiF32 E; E.C = (float*)(p.big + BIG_Y); E.ldc = 1024;
            run_gemm(cx, smem, (const bf16_t*)(p.big + BIG_V), p.WdownT + (size_t)l * 1024 * DFF, l == 1 ? LROWS : MROWS, 1024, DFF, E); } break;
        case 11: phase_ln_res(cx, p, l, 1); break;
    }
}

__global__ void __launch_bounds__(512, 2) mega(Params p) {
    extern __shared__ __attribute__((aligned(16))) unsigned char smem[];
    bool first = true;
    for (int ph = p.ph_lo; ph < p.ph_hi; ++ph) {
        if (ph == 13) continue;
        if (!first) cg::this_grid().sync();
        first = false;
        Ctx cx; { int t_ = threadIdx.x, b_ = blockIdx.x, n_ = gridDim.x; asm volatile("" : "+v"(t_)); asm volatile("" : "+s"(b_)); asm volatile("" : "+s"(n_)); cx.tid = t_; cx.bid = b_; cx.nb = n_; }
        const __attribute__((address_space(4))) Params* kp = (const __attribute__((address_space(4))) Params*)__builtin_amdgcn_kernarg_segment_ptr();
        asm volatile("" : "+s"(kp));
        run_phase(cx, *kp, ph, smem);
    }
}

extern "C" void kernel_launch(void* const* d_in, const int* in_sizes, int n_in, void* d_out, int out_size, void* d_ws, size_t ws_size, hipStream_t stream) {
    static int grid = 0;
    if (grid == 0) {
        if (n_in != 32 || ws_size < WS_END) { fprintf(stderr, "kernel_launch: need 32 inputs and %zu bytes of workspace (got %d, %zu)\n", (size_t)WS_END, n_in, ws_size); grid = -1; return; }
        int dev = 0, cus = 0, per_cu = 0;
        (void)hipGetDevice(&dev); (void)hipDeviceGetAttribute(&cus, hipDeviceAttributeMultiprocessorCount, dev);
        if (hipFuncSetAttribute((const void*)mega, hipFuncAttributeMaxDynamicSharedMemorySize, LDS_BYTES) != hipSuccess) { fprintf(stderr, "kernel_launch: hipFuncSetAttribute failed\n"); grid = -1; return; }
        if (hipOccupancyMaxActiveBlocksPerMultiprocessor(&per_cu, (const void*)mega, NTHR, LDS_BYTES) != hipSuccess || per_cu < 1) { fprintf(stderr, "kernel_launch: occupancy query gave %d\n", per_cu); per_cu = 1; }
        (void)hipGetLastError();
        grid = cus * per_cu;
    }
    if (grid < 0) return;
    Params p{};
    const float** pin = (const float**)&p;
    for (int i = 0; i < 32; ++i) pin[i] = (const float*)d_in[i];
    unsigned char* ws = (unsigned char*)d_ws;
    p.out = (float*)d_out;
    p.WinT = (bf16_t*)(ws + WS_WIN); p.WoutT = (bf16_t*)(ws + WS_WOUT); p.WupT = (bf16_t*)(ws + WS_WUP); p.WdownT = (bf16_t*)(ws + WS_WDOWN); p.WgluT = (bf16_t*)(ws + WS_WGLU);
    p.mod = (float*)(ws + WS_MOD); p.M2T = (bf16_t*)(ws + WS_M2T); p.McatT = (bf16_t*)(ws + WS_MCAT); p.L16 = (float*)(ws + WS_L16); p.hc = (float*)(ws + WS_HC);
    p.A1 = (bf16_t*)(ws + WS_A1); p.big = ws + WS_BIG;
#if COOP
    p.ph_lo = 0; p.ph_hi = 25;
    void* args[] = {&p};
    hipError_t e = hipLaunchCooperativeKernel((const void*)mega, dim3(grid), dim3(NTHR), args, LDS_BYTES, stream);
    if (e != hipSuccess) fprintf(stderr, "cooperative launch failed: %s (grid %d)\n", hipGetErrorString(e), grid);
#else
    for (int ph = 0; ph < 25; ++ph) {
        if (ph == 13) continue;
        p.ph_lo = ph; p.ph_hi = ph + 1;
        hipLaunchKernelGGL(mega, dim3(grid), dim3(NTHR), LDS_BYTES, stream, p);
    }
#endif
}
```

```cpp
#include <hip/hip_runtime.h>
#include <hip/hip_cooperative_groups.h>
#include <cstdio>
namespace cg = cooperative_groups;

#ifndef COOP
#define COOP 1
#endif

#define LAS __attribute__((address_space(3)))
typedef unsigned short bf16_t;
typedef short bf16x8 __attribute__((ext_vector_type(8)));
typedef float f32x4 __attribute__((ext_vector_type(4)));
typedef float f32x2 __attribute__((ext_vector_type(2)));
typedef unsigned u32x4 __attribute__((ext_vector_type(4)));
typedef unsigned u32x2 __attribute__((ext_vector_type(2)));

constexpr int NTHR = 512;
constexpr int MROWS = 33792, LROWS = 32768, DM = 1024, ZLD = 3072, DFF = 2816, DIN = 2992;
constexpr int LDS_MAIN = 150 * 1024;
constexpr int LDS_BYTES = LDS_MAIN + 16;
constexpr float ALPHA_C = 1.41421356237f;
constexpr int ZC_U5 = 0, ZC_GQ = 256, ZC_GK = 448, ZC_GV = 640, ZC_GR = 1024, ZC_GLR = 1408, ZC_MQ = 1440, ZC_MK = 1824, ZC_MV = 2208, ZC_MO = 2592, ZC_MIG = 2976, ZC_MFG = 2984;

struct Params {
    const float *x, *c, *ctx, *c_ctx, *w_ada, *b_ada, *w_in, *s5_a_re, *s5_a_im, *s5_log_dt, *s5_b_re, *s5_b_im, *s5_c_re, *s5_c_im, *s5_d, *s5_w_glu, *s5_b_glu,
        *gla_w_a2, *gla_b_a, *gla_g, *ml_i_bias, *ml_f_bias, *ml_g, *w_out, *ln1_g, *ln1_b, *w_up, *w_dconv, *b_dconv, *w_down, *ln2_g, *ln2_b;
    float* out;
    bf16_t *WinT, *WoutT, *WupT, *WdownT, *WgluT;
    float* mod;
    bf16_t *M2T, *McatT;
    float* L16;
    float* hc;
    bf16_t* A1;
    unsigned char* big;
    unsigned* bar;
    int ph_lo, ph_hi;
};

#define PRM const __attribute__((address_space(4))) Params&
constexpr size_t WS_WIN = 0;
constexpr size_t WS_WOUT = WS_WIN + 2ull * 3072 * 1024 * 2;
constexpr size_t WS_WUP = WS_WOUT + 2ull * 1024 * 1024 * 2;
constexpr size_t WS_WDOWN = WS_WUP + 2ull * 5632 * 1024 * 2;
constexpr size_t WS_WGLU = WS_WDOWN + 2ull * 1024 * 2816 * 2;
constexpr size_t WS_MOD = WS_WGLU + 2ull * 256 * 256 * 2;
constexpr size_t WS_M2T = WS_MOD + 2ull * 5 * 6144 * 4;
constexpr size_t WS_MCAT = WS_M2T + 2ull * 16 * 256 * 256 * 2;
constexpr size_t WS_L16 = WS_MCAT + 2ull * 16 * 256 * 512 * 2;
constexpr size_t WS_HC = WS_L16 + 2ull * 2 * 16 * 64 * 2 * 4;
constexpr size_t WS_A1 = WS_HC + 1024ull * 1024 * 4;
constexpr size_t WS_BIG = WS_A1 + (size_t)MROWS * 1024 * 2;
constexpr size_t BIG_BYTES = (size_t)MROWS * 5632 * 2;
constexpr size_t WS_BAR = WS_BIG + BIG_BYTES;
constexpr size_t WS_END = WS_BAR + 16384;
constexpr size_t BIG_Z = 0;
constexpr size_t BIG_OBUF = BIG_Z + (size_t)MROWS * ZLD * 2;
constexpr size_t BIG_LOC = BIG_OBUF + 2ull * MROWS * 768 * 2;
constexpr size_t BIG_XE = BIG_LOC + 2ull * 4 * 16 * 528 * 128 * 4;
constexpr size_t BIG_G5 = BIG_XE + 2ull * 4 * 528 * 16 * 128 * 2;
constexpr size_t BIG_Y = 0;
constexpr size_t BIG_A = 0;
constexpr size_t BIG_V = (size_t)MROWS * DFF * 2;
static_assert(BIG_G5 + (size_t)MROWS * 256 * 2 <= BIG_BYTES, "big map");
constexpr size_t A1_QD = 0;
constexpr size_t A1_KD = A1_QD + (size_t)MROWS * 384 * 2;
constexpr size_t A1_BL = A1_KD + (size_t)MROWS * 384 * 2;
constexpr size_t A1_G4 = A1_BL + 528ull * 8 * 48 * 4;
constexpr size_t A1_CH = A1_G4 + (size_t)MROWS * 32 * 4;
constexpr size_t A1_DN = A1_CH + 528ull * 8 * 2 * 4;
constexpr size_t A1_DI = A1_DN + 528ull * 8 * 96 * 4;
constexpr size_t A1_MLS = A1_DI + (size_t)MROWS * 8 * 4;
constexpr size_t A1_MLN = A1_MLS + 96ull * 2 * 256 * 12 * 4;
constexpr size_t A1_GLS = A1_MLN + 96ull * 2 * 128 * 4;
static_assert(A1_GLS + 96ull * 256 * 8 * 4 <= (size_t)MROWS * 1024 * 2, "a1 map");

struct Ctx { int tid, bid, nb; };
__device__ __forceinline__ float bf2f(bf16_t b) { return __uint_as_float(((unsigned)b) << 16); }
typedef __bf16 bf16v2_t __attribute__((ext_vector_type(2)));
__device__ __forceinline__ bf16_t f2bf(float f) { return __builtin_bit_cast(unsigned short, (__bf16)f); }
__device__ __forceinline__ unsigned pk2(float lo, float hi) { bf16v2_t v; v[0] = (__bf16)lo; v[1] = (__bf16)hi; return __builtin_bit_cast(unsigned, v); }
__device__ __forceinline__ float lo2f(unsigned w) { return __uint_as_float(w << 16); }
__device__ __forceinline__ float hi2f(unsigned w) { return __uint_as_float(w & 0xFFFF0000u); }
__device__ __forceinline__ float sigmoidf_(float x) { return 1.0f / (1.0f + __expf(-x)); }
__device__ __forceinline__ float logsigmoidf_(float x) { return fminf(x, 0.f) - log1pf(__expf(-fabsf(x))); }
__device__ __forceinline__ float gelu_tanh(float x) { const float u = 0.7978845608f * (x + 0.044715f * x * x * x); const float t = 1.0f - 2.0f / (__expf(2.0f * u) + 1.0f); return 0.5f * x * (1.0f + t); }
__device__ __forceinline__ float siluf_(float x) { return x / (1.0f + __expf(-x)); }
__device__ __forceinline__ int mod_row(int row) { return row < LROWS ? (row >> 13) : 4; }
__device__ __forceinline__ float wave_sum(float v) {
#pragma unroll
    for (int o = 32; o > 0; o >>= 1) v += __shfl_xor(v, o, 64);
    return v;
}
__device__ __forceinline__ float wave_max(float v) {
#pragma unroll
    for (int o = 32; o > 0; o >>= 1) v = fmaxf(v, __shfl_xor(v, o, 64));
    return v;
}
__device__ __forceinline__ f32x4 mfma16(bf16x8 a, bf16x8 b, f32x4 c) { return __builtin_amdgcn_mfma_f32_16x16x32_bf16(a, b, c, 0, 0, 0); }

namespace pg8 {
constexpr int BM = 256, BK = 64, HALF = 128, HTB = HALF * BK * 2, STAGE_BYTES = 8 * HTB, NXCD = 8, WGM = 8;
__device__ __forceinline__ int lds_byte(int r, int c) { const int st = (r >> 4) * 2 + (c >> 5), rr = r & 15, cc = c & 31, ob = rr * 64 + cc * 2; return st * 1024 + (ob ^ (((ob >> 9) & 1) << 5)); }
__device__ __forceinline__ void stage_rc(int b, int& R, int& C) { const int st = b / 1024, sb = b % 1024, swz = sb ^ (((sb >> 9) & 1) << 5); R = (st >> 1) * 16 + swz / 64; C = (st & 1) * 32 + (swz % 64) / 2; }
__device__ __forceinline__ int perm32(int rho) { const int n = rho >> 4, i = rho & 15; return 8 * (i >> 2) + 4 * n + (i & 3); }
struct Unit { int pm, pn; };
struct Gemm { const bf16_t* A; const bf16_t* Bt; int M, N, K; };
struct StaticOrder {
    int nM, nN, nwg, G, c;
    __device__ void init(int M, int N, int G_, int c_) { nM = M / BM; nN = N / BM; nwg = nM * nN; G = G_; c = c_; }
    __device__ bool next(int i, Unit& u) const {
        const long L = (long)i * G + c; if (L >= nwg) return false;
        int wgid = (int)L; { const int q = nwg / NXCD, r = nwg % NXCD, xcd = wgid % NXCD, off = wgid / NXCD; wgid = (xcd < r ? xcd * (q + 1) : r * (q + 1) + (xcd - r) * q) + off; }
        const int nig = WGM * nN, gid = wgid / nig, fm = gid * WGM, gsz = (nM - fm) < WGM ? (nM - fm) : WGM;
        u.pm = fm + ((wgid % nig) % gsz); u.pn = (wgid % nig) / gsz; return true;
    }
    __device__ __forceinline__ void a_ready(const Unit&) const {}
    __device__ __forceinline__ void done(const Unit&) const {}
};
__device__ __forceinline__ unsigned cvt_pk_bf16(float lo, float hi) { return pk2(lo, hi); }

struct EpiF32 {
    static constexpr bool PERM = false;
    float* C; int ldc;
    __device__ __forceinline__ void operator()(const f32x4 (&acc)[2][2][4][2], const Unit& u, int wr, int wc, int fr, int fq) const {
        const int row0 = u.pm * BM + wr * 64 + fr, col0 = u.pn * BM + wc * 32 + 4 * fq;
#pragma unroll
        for (int ai = 0; ai < 2; ++ai)
#pragma unroll
            for (int m = 0; m < 4; ++m) { float* rowp = C + (size_t)(row0 + ai * HALF + m * 16) * ldc + col0;
#pragma unroll
                for (int bj = 0; bj < 2; ++bj)
#pragma unroll
                    for (int n = 0; n < 2; ++n) *(f32x4*)(rowp + bj * HALF + n * 16) = acc[ai][bj][m][n]; }
    }
};
struct EpiBf16 {
    static constexpr bool PERM = true;
    bf16_t* O; int ldc; int split_cols; size_t split_stride;
    __device__ __forceinline__ void operator()(const f32x4 (&acc)[2][2][4][2], const Unit& u, int wr, int wc, int fr, int fq) const {
        const int row0 = u.pm * BM + wr * 64 + fr; int colt = u.pn * BM; bf16_t* base = O;
        if (split_cols) { const int t = colt / split_cols; base += (size_t)t * split_stride; colt -= t * split_cols; }
        const int col0 = colt + wc * 32 + 8 * fq;
#pragma unroll
        for (int ai = 0; ai < 2; ++ai)
#pragma unroll
            for (int m = 0; m < 4; ++m) { bf16_t* rowp = base + (size_t)(row0 + ai * HALF + m * 16) * ldc + col0;
#pragma unroll
                for (int bj = 0; bj < 2; ++bj) { const f32x4 v0 = acc[ai][bj][m][0], v1 = acc[ai][bj][m][1];
                    u32x4 w; w.x = cvt_pk_bf16(v0[0], v0[1]); w.y = cvt_pk_bf16(v0[2], v0[3]); w.z = cvt_pk_bf16(v1[0], v1[1]); w.w = cvt_pk_bf16(v1[2], v1[3]);
                    *(u32x4*)(rowp + bj * HALF) = w; } }
    }
};
template <class Epi, class Sched>
__device__ __forceinline__ void gemm_phase(const Ctx& cx, LAS unsigned char* lds, const Gemm g, const Sched& S, const Epi& E) {
    const int tid = cx.tid, wid = __builtin_amdgcn_readfirstlane(tid >> 6), lane = tid & 63, wr = wid >> 2, wc = wid & 3, fr = lane & 15, fq = lane >> 4;
    const int K = g.K, nt = K / BK;
    unsigned voffA[2], voffB[2];
#pragma unroll
    for (int i = 0; i < 2; ++i) { int R, C; stage_rc(tid * 16 + i * 8192, R, C); const int Rb = Epi::PERM ? ((R & ~31) + perm32(R & 31)) : R;
        voffA[i] = (unsigned)(R * K + C) * 2u; voffB[i] = (unsigned)(Rb * K + C) * 2u; }
    const size_t kstep = (size_t)(BK * 2);
    const size_t hstep = (size_t)HALF * K * 2;
    const size_t tstep = 2 * hstep;
    const unsigned ldsw = (unsigned)wid * 1024u;
    const int aoff = lds_byte(wr * 64 + fr, fq * 8), boff = lds_byte(wc * 32 + fr, fq * 8);
#define PG8_SA(b, h) (((b) * 2 + (h)) * HTB)
#define PG8_SB(b, h) ((4 + (b) * 2 + (h)) * HTB)
#define PG8_STAGE(bufoff, gbase, voff) do { _Pragma("unroll") for (int _i = 0; _i < 2; ++_i) \
        __builtin_amdgcn_global_load_lds((const unsigned*)((const char*)(gbase) + (voff)[_i]), (LAS unsigned*)(lds + (bufoff) + ldsw + _i * 8192), 16, 0, 0); } while (0)
#define PG8_LDA(dst, b, h) do { _Pragma("unroll") for (int m = 0; m < 4; ++m) _Pragma("unroll") for (int k = 0; k < 2; ++k) dst[m][k] = *(const LAS bf16x8*)(lds + PG8_SA(b, h) + aoff + m * 2048 + k * 1024); } while (0)
#define PG8_LDB(dst, b, h) do { _Pragma("unroll") for (int n = 0; n < 2; ++n) _Pragma("unroll") for (int k = 0; k < 2; ++k) dst[n][k] = *(const LAS bf16x8*)(lds + PG8_SB(b, h) + boff + n * 2048 + k * 1024); } while (0)
#define PG8_MMA(ai, bj, At, Bt) do { __builtin_amdgcn_s_setprio(1); _Pragma("unroll") for (int m = 0; m < 4; ++m) _Pragma("unroll") for (int n = 0; n < 2; ++n) _Pragma("unroll") for (int k = 0; k < 2; ++k) \
        acc[ai][bj][m][n] = __builtin_amdgcn_mfma_f32_16x16x32_bf16(Bt[n][k], At[m][k], acc[ai][bj][m][n], 0, 0, 0); __builtin_amdgcn_s_setprio(0); } while (0)
#define PG8_WAIT_V(n) asm volatile("s_waitcnt vmcnt(" #n ")" ::: "memory")
#define PG8_WAIT_L(n) asm volatile("s_waitcnt lgkmcnt(" #n ")" ::: "memory")
#define PG8_BAR __builtin_amdgcn_s_barrier()
#define PG8_SCHED __builtin_amdgcn_sched_barrier(0)
    Unit cur, nxt; int ui = 0;
    if (!S.next(0, cur)) return;
    f32x4 acc[2][2][4][2];
#pragma unroll
    for (int a = 0; a < 2; ++a)
#pragma unroll
        for (int b = 0; b < 2; ++b)
#pragma unroll
            for (int m = 0; m < 4; ++m)
#pragma unroll
                for (int n = 0; n < 2; ++n) acc[a][b][m][n] = (f32x4){0.f, 0.f, 0.f, 0.f};
    bf16x8 At[4][2], B0[2][2], B1[2][2];
    const char* cA = (const char*)g.A + (size_t)cur.pm * tstep; const char* cB = (const char*)g.Bt + (size_t)cur.pn * tstep;
    S.a_ready(cur);
    PG8_STAGE(PG8_SB(0, 0), cB, voffB); PG8_STAGE(PG8_SA(0, 0), cA, voffA); PG8_STAGE(PG8_SB(0, 1), cB + hstep, voffB); PG8_STAGE(PG8_SA(0, 1), cA + hstep, voffA);
    if (wr == 1) PG8_BAR;
    PG8_WAIT_V(4); PG8_BAR;
    PG8_STAGE(PG8_SB(1, 0), cB + kstep, voffB); PG8_STAGE(PG8_SA(1, 0), cA + kstep, voffA); PG8_STAGE(PG8_SB(1, 1), cB + hstep + kstep, voffB);
    PG8_WAIT_V(6); PG8_BAR;
    for (;;) {
        const bool has_next = S.next(ui + 1, nxt);
        const char* nA = has_next ? (const char*)g.A + (size_t)nxt.pm * tstep : cA; const char* nB = has_next ? (const char*)g.Bt + (size_t)nxt.pn * tstep : cB;
        for (int t = 0; t < nt; t += 2) {
            const bool last = (t == nt - 2);
            const char* a1 = cA + (size_t)(t + 1) * kstep;
            const char* a2 = last ? nA : cA + (size_t)(t + 2) * kstep; const char* b2 = last ? nB : cB + (size_t)(t + 2) * kstep;
            const char* a3 = a2 + kstep; const char* b3 = b2 + kstep;
            if (last && has_next) S.a_ready(nxt);
            PG8_LDB(B0, 0, 0); PG8_SCHED; PG8_LDA(At, 0, 0); PG8_STAGE(PG8_SA(1, 1), a1 + hstep, voffA);
            PG8_WAIT_L(8); PG8_BAR; PG8_WAIT_L(0); PG8_MMA(0, 0, At, B0); PG8_BAR; PG8_SCHED;
            PG8_LDB(B1, 0, 1); PG8_STAGE(PG8_SB(0, 0), b2, voffB);
            PG8_BAR; PG8_WAIT_L(0); PG8_MMA(0, 1, At, B1); PG8_BAR;
            PG8_LDA(At, 0, 1); PG8_STAGE(PG8_SA(0, 0), a2, voffA);
            PG8_BAR; PG8_WAIT_L(0); PG8_MMA(1, 0, At, B0); PG8_BAR; PG8_SCHED;
            PG8_STAGE(PG8_SB(0, 1), b2 + hstep, voffB);
            PG8_WAIT_V(6); PG8_BAR; PG8_MMA(1, 1, At, B1); PG8_BAR;
            PG8_LDB(B0, 1, 0); PG8_SCHED; PG8_LDA(At, 1, 0); PG8_STAGE(PG8_SA(0, 1), a2 + hstep, voffA);
            PG8_WAIT_L(8); PG8_BAR; PG8_WAIT_L(0); PG8_MMA(0, 0, At, B0); PG8_BAR; PG8_SCHED;
            PG8_LDB(B1, 1, 1); PG8_STAGE(PG8_SB(1, 0), b3, voffB);
            PG8_BAR; PG8_WAIT_L(0); PG8_MMA(0, 1, At, B1); PG8_BAR;
            PG8_LDA(At, 1, 1); PG8_STAGE(PG8_SA(1, 0), a3, voffA);
            PG8_BAR; PG8_WAIT_L(0); PG8_MMA(1, 0, At, B0); PG8_BAR; PG8_SCHED;
            PG8_STAGE(PG8_SB(1, 1), b3 + hstep, voffB);
            PG8_WAIT_V(6); PG8_BAR; PG8_MMA(1, 1, At, B1); PG8_BAR;
        }
        E(acc, cur, wr, wc, fr, fq); S.done(cur);
        if (!has_next) break;
#pragma unroll
        for (int a = 0; a < 2; ++a)
#pragma unroll
            for (int b = 0; b < 2; ++b)
#pragma unroll
                for (int m = 0; m < 4; ++m)
#pragma unroll
                    for (int n = 0; n < 2; ++n) acc[a][b][m][n] = (f32x4){0.f, 0.f, 0.f, 0.f};
        cur = nxt; cA = nA; cB = nB; ++ui;
    }
    PG8_WAIT_V(0);
    if (wr == 0) PG8_BAR;
    PG8_BAR;
#undef PG8_SA
#undef PG8_SB
#undef PG8_STAGE
#undef PG8_LDA
#undef PG8_LDB
#undef PG8_MMA
#undef PG8_WAIT_V
#undef PG8_WAIT_L
#undef PG8_BAR
#undef PG8_SCHED
}
}

template <class Epi>
__device__ __forceinline__ void run_gemm(const Ctx& cx, unsigned char* smem, const bf16_t* A, const bf16_t* Bt, int M, int N, int K, const Epi& E) {
    pg8::Gemm g; g.A = A; g.Bt = Bt; g.M = M; g.N = N; g.K = K;
    pg8::StaticOrder S; S.init(M, N, (int)cx.nb, (int)cx.bid);
    pg8::gemm_phase<Epi, pg8::StaticOrder>(cx, (LAS unsigned char*)smem, g, S, E);
}

__device__ void p0_s5_setup(const Ctx& cx, PRM p, int u, unsigned char* smem) {
    const int l = u >> 5, g = (u >> 1) & 15, th = u & 1, tid = cx.tid;
    float* LP = (float*)smem;
    float* BB = LP + 2 * 17 * 64 * 2;
    float* CC = BB + 2 * 64 * 16 * 2;
    __syncthreads();
    for (int i = tid; i < 2 * 17 * 64; i += NTHR) {
        const int d = i / (17 * 64), n = (i / 64) % 17, pp = i & 63;
        const int gi = ((l * 2 + d) * 16 + g);
        const float dt = expf(p.s5_log_dt[gi]); const float ar = p.s5_a_re[gi * 64 + pp], ai = p.s5_a_im[gi * 64 + pp];
        const float mag = expf(ar * dt * (float)n); float sn, cs; sincosf(ai * dt * (float)n, &sn, &cs);
        LP[i * 2] = mag * cs; LP[i * 2 + 1] = mag * sn;
    }
    for (int i = tid; i < 2 * 16 * 64; i += NTHR) {
        const int d = i / 1024, hh = (i / 64) & 15, pp = i & 63;
        const size_t gi = ((size_t)(l * 2 + d) * 16 + g);
        CC[i * 2] = p.s5_c_re[(gi * 16 + hh) * 64 + pp]; CC[i * 2 + 1] = p.s5_c_im[(gi * 16 + hh) * 64 + pp];
    }
    __syncthreads();
    for (int i = tid; i < 2 * 64 * 16; i += NTHR) {
        const int d = i / 1024, pp = (i / 16) & 63, hh = i & 15;
        const int gi = ((l * 2 + d) * 16 + g);
        const float ar = p.s5_a_re[gi * 64 + pp], ai = p.s5_a_im[gi * 64 + pp];
        const float lr = LP[((d * 17 + 1) * 64 + pp) * 2], li = LP[((d * 17 + 1) * 64 + pp) * 2 + 1];
        const float den = ar * ar + ai * ai;
        const float zr = ((lr - 1.0f) * ar + li * ai) / den, zi = (li * ar - (lr - 1.0f) * ai) / den;
        const float br = p.s5_b_re[((size_t)gi * 64 + pp) * 16 + hh], bi = p.s5_b_im[((size_t)gi * 64 + pp) * 16 + hh];
        BB[i * 2] = zr * br - zi * bi; BB[i * 2 + 1] = zr * bi + zi * br;
    }
    __syncthreads();
    float* KT = CC + 2 * 16 * 64 * 2;
    for (int e0 = tid; e0 < 6144; e0 += NTHR) {
        const int sh = th == 0 ? 2048 : 4096;
        const int d = e0 < sh ? 0 : 1, e = d == 0 ? e0 : 4096 + (e0 - sh);
        const int tau = (e >> 8) & 15, hh = (e >> 4) & 15, h2 = e & 15; float acc = 0.f;
        for (int pp = 0; pp < 64; ++pp) {
            const float Lr = LP[((d * 17 + tau) * 64 + pp) * 2], Li = LP[((d * 17 + tau) * 64 + pp) * 2 + 1];
            const float br = BB[((d * 64 + pp) * 16 + h2) * 2], bi = BB[((d * 64 + pp) * 16 + h2) * 2 + 1];
            const float cr = CC[((d * 16 + hh) * 64 + pp) * 2], ci = CC[((d * 16 + hh) * 64 + pp) * 2 + 1];
            const float wr = Lr * br - Li * bi, wi = Lr * bi + Li * br;
            acc += cr * wr - ci * wi; }
        KT[e] = acc;
    }
    __syncthreads();
    bf16_t* mc = p.McatT + (size_t)(l * 16 + g) * 256 * 512 + (size_t)th * 128 * 512;
    for (int e = tid; e < 128 * 512; e += NTHR) {
        const int n = th * 128 + (e >> 9), k = e & 511, t = n >> 4, hh = n & 15; float val = 0.f;
        if (k < 256) {
            const int s = k >> 4, h2 = k & 15;
            if (t >= s) val += KT[((0 * 16 + (t - s)) * 16 + hh) * 16 + h2];
            if (s >= t) val += KT[((1 * 16 + (s - t)) * 16 + hh) * 16 + h2];
            if (s == t && h2 == hh) val += p.s5_d[l * 256 + g * 16 + hh];
        } else {
            const int kk = k - 256, d = kk >> 7, part = (kk >> 6) & 1, pp = kk & 63, npow = d == 0 ? t + 1 : 16 - t;
            const float Lr = LP[((d * 17 + npow) * 64 + pp) * 2], Li = LP[((d * 17 + npow) * 64 + pp) * 2 + 1];
            const float cr = CC[((d * 16 + hh) * 64 + pp) * 2], ci = CC[((d * 16 + hh) * 64 + pp) * 2 + 1];
            val = part == 0 ? (cr * Lr - ci * Li) : -(cr * Li + ci * Lr);
        }
        mc[e] = f2bf(val);
    }
    bf16_t* m2 = p.M2T + (size_t)(l * 16 + g) * 256 * 256 + (size_t)th * 128 * 256;
    for (int e = tid; e < 128 * 256; e += NTHR) {
        const int n2 = th * 128 + (e >> 8), k = e & 255, d = n2 >> 7, part = (n2 >> 6) & 1, pp = n2 & 63, s = k >> 4, h2 = k & 15;
        const int ex = d == 0 ? 15 - s : s;
        const float Lr = LP[((d * 17 + ex) * 64 + pp) * 2], Li = LP[((d * 17 + ex) * 64 + pp) * 2 + 1];
        const float br = BB[((d * 64 + pp) * 16 + h2) * 2], bi = BB[((d * 64 + pp) * 16 + h2) * 2 + 1];
        m2[e] = f2bf(part == 0 ? (Lr * br - Li * bi) : (Lr * bi + Li * br));
    }
    if (th == 0 && tid < 128) { const int d = tid >> 6, pp = tid & 63;
        float* o = p.L16 + ((size_t)((l * 2 + d) * 16 + g) * 64 + pp) * 2;
        o[0] = LP[((d * 17 + 16) * 64 + pp) * 2]; o[1] = LP[((d * 17 + 16) * 64 + pp) * 2 + 1]; }
}

__device__ void p0_mod(const Ctx& cx, PRM p, int u, unsigned char* smem) {
    const int l = u / 48, cb = u % 48, tid = cx.tid;
    float* sc = (float*)smem;
    float* red = sc + 5 * 1024;
    __syncthreads();
    for (int i = tid; i < 5 * 1024; i += NTHR) { const int r = i >> 10, k = i & 1023; const float v = r < 4 ? p.c[r * 1024 + k] : p.c_ctx[k]; sc[i] = siluf_(v); }
    __syncthreads();
    const int col = tid & 127, part = tid >> 7, j = cb * 128 + col;
    float a0 = 0.f, a1 = 0.f, a2 = 0.f, a3 = 0.f, a4 = 0.f;
    const float* w = p.w_ada + (size_t)l * 1024 * 6144 + j;
    for (int i = part * 256; i < part * 256 + 256; ++i) { const float wv = w[(size_t)i * 6144];
        a0 += sc[i] * wv; a1 += sc[1024 + i] * wv; a2 += sc[2048 + i] * wv; a3 += sc[3072 + i] * wv; a4 += sc[4096 + i] * wv; }
    red[(part * 5 + 0) * 128 + col] = a0; red[(part * 5 + 1) * 128 + col] = a1; red[(part * 5 + 2) * 128 + col] = a2; red[(part * 5 + 3) * 128 + col] = a3; red[(part * 5 + 4) * 128 + col] = a4;
    __syncthreads();
    for (int o = tid; o < 640; o += NTHR) { const int r = o >> 7, cc = o & 127, jj = cb * 128 + cc;
        const float s = red[(0 * 5 + r) * 128 + cc] + red[(1 * 5 + r) * 128 + cc] + red[(2 * 5 + r) * 128 + cc] + red[(3 * 5 + r) * 128 + cc];
        p.mod[((size_t)l * 5 + r) * 6144 + jj] = s + p.b_ada[l * 6144 + jj]; }
}

__device__ void p0_transpose(const Ctx& cx, const float* __restrict__ src, bf16_t* __restrict__ dst, int K, int N, int u, int nkt, unsigned char* smem, bool win = false) {
    const int nt_ = u / nkt, kt = u % nkt, tid = cx.tid;
    float* tile = (float*)smem;
    __syncthreads();
    {
        const int cc = tid & 255, n = nt_ * 256 + cc, r0 = tid >> 8;
        float sc_ = 1.0f; if (win) { if (n >= ZC_GQ && n < ZC_GK) sc_ = 0.14433756729f; else if (n >= ZC_MK && n < ZC_MV) sc_ = 0.10206207261f; }
        const float* sp = src + (size_t)(kt * 64 + r0) * N + n;
        float v[32];
#pragma unroll
        for (int i = 0; i < 32; ++i) v[i] = n < N ? sp[(size_t)(2 * i) * N] : 0.f;
#pragma unroll
        for (int i = 0; i < 32; ++i) tile[(r0 + 2 * i) * 257 + cc] = v[i] * sc_;
    }
    __syncthreads();
#pragma unroll
    for (int j = 0; j < 4; ++j) {
        const int cc = (tid >> 3) + 64 * j, r0 = (tid & 7) * 8;
        u32x4 w;
        w.x = pk2(tile[(r0 + 0) * 257 + cc], tile[(r0 + 1) * 257 + cc]); w.y = pk2(tile[(r0 + 2) * 257 + cc], tile[(r0 + 3) * 257 + cc]);
        w.z = pk2(tile[(r0 + 4) * 257 + cc], tile[(r0 + 5) * 257 + cc]); w.w = pk2(tile[(r0 + 6) * 257 + cc], tile[(r0 + 7) * 257 + cc]);
        *(u32x4*)(dst + (size_t)(nt_ * 256 + cc) * K + kt * 64 + r0) = w;
    }
}

__device__ void phase0(const Ctx& cx, PRM p, unsigned char* smem) {
    constexpr int U_S5 = 64, U_MOD = 96, U_L = 788, U_TOT = U_MOD + 2 * U_L;
    if (cx.bid < U_S5) { p0_s5_setup(cx, p, cx.bid, smem); return; }
    for (int u = cx.bid - U_S5; u < U_TOT; u += cx.nb - U_S5) {
        if (u < U_MOD) p0_mod(cx, p, u, smem);
        else {
            int v = u - U_MOD; const int l = v / U_L; v -= l * U_L;
            const float* src; bf16_t* dst; int K_, N_, nkt_; bool win_ = false;
            if (v < 192) { src = p.w_in + (size_t)l * 1024 * DIN; dst = p.WinT + (size_t)l * 3072 * 1024; K_ = 1024; N_ = DIN; nkt_ = 16; win_ = true; }
            else if (v < 256) { v -= 192; src = p.w_out + (size_t)l * 1024 * 1024; dst = p.WoutT + (size_t)l * 1024 * 1024; K_ = 1024; N_ = 1024; nkt_ = 16; }
            else if (v < 608) { v -= 256; src = p.w_up + (size_t)l * 1024 * 5632; dst = p.WupT + (size_t)l * 5632 * 1024; K_ = 1024; N_ = 5632; nkt_ = 16; }
            else if (v < 784) { v -= 608; src = p.w_down + (size_t)l * DFF * 1024; dst = p.WdownT + (size_t)l * 1024 * DFF; K_ = DFF; N_ = 1024; nkt_ = 44; }
            else { v -= 784; src = p.s5_w_glu + (size_t)l * 256 * 256; dst = p.WgluT + (size_t)l * 256 * 256; K_ = 256; N_ = 256; nkt_ = 4; }
            p0_transpose(cx, src, dst, K_, N_, v, nkt_, smem, win_);
        }
    }
}

__device__ __forceinline__ void ln_stats16(const float (&v)[16], float& mu, float& rstd) {
    float s = 0.f;
#pragma unroll
    for (int i = 0; i < 16; ++i) s += v[i];
    mu = wave_sum(s) * (1.0f / 1024.0f);
    float q = 0.f;
#pragma unroll
    for (int i = 0; i < 16; ++i) { const float d = v[i] - mu; q += d * d; }
    rstd = rsqrtf(wave_sum(q) * (1.0f / 1024.0f) + 1e-5f);
}
__device__ __forceinline__ void store_mod_bf16(bf16_t* dst, const float (&v)[16], const float* sh, const float* sc, int lane) {
    float mu, rstd; ln_stats16(v, mu, rstd);
#pragma unroll
    for (int i = 0; i < 4; ++i) { const int c0 = lane * 4 + 256 * i;
        const f32x4 s4 = *(const f32x4*)(sh + c0), c4 = *(const f32x4*)(sc + c0);
        float o[4];
#pragma unroll
        for (int j = 0; j < 4; ++j) o[j] = (v[i * 4 + j] - mu) * rstd * (1.0f + c4[j]) + s4[j];
        u32x2 w; w.x = pk2(o[0], o[1]); w.y = pk2(o[2], o[3]);
        *(u32x2*)(dst + c0) = w; }
}
__device__ void phase_ln_first(const Ctx& cx, PRM p) {
    const int wid = cx.tid >> 6, lane = cx.tid & 63;
    for (int row = cx.bid * 8 + wid; row < MROWS; row += cx.nb * 8) {
        const float* src = row < LROWS ? p.x + (size_t)row * 1024 : p.ctx + (size_t)(row - LROWS) * 1024;
        float v[16];
#pragma unroll
        for (int i = 0; i < 4; ++i) { const f32x4 t = *(const f32x4*)(src + lane * 4 + 256 * i); v[i * 4] = t[0]; v[i * 4 + 1] = t[1]; v[i * 4 + 2] = t[2]; v[i * 4 + 3] = t[3]; }
        const float* md = p.mod + (size_t)(0 * 5 + mod_row(row)) * 6144;
        store_mod_bf16(p.A1 + (size_t)row * 1024, v, md + 0 * 1024, md + 1 * 1024, lane);
    }
}
__device__ __forceinline__ void sub_barrier(const Ctx& cx, unsigned* ctr, unsigned nblk) {
    asm volatile("s_waitcnt vmcnt(0)" ::: "memory");
    __syncthreads();
    if (cx.tid == 0) {
        __builtin_amdgcn_fence(__ATOMIC_RELEASE, "agent");
        asm volatile("s_waitcnt vmcnt(0)" ::: "memory");
        __hip_atomic_fetch_add(ctr, 1u, __ATOMIC_RELAXED, __HIP_MEMORY_SCOPE_AGENT);
        unsigned sp = 0;
        while (__hip_atomic_load(ctr, __ATOMIC_RELAXED, __HIP_MEMORY_SCOPE_AGENT) < nblk) { __builtin_amdgcn_s_sleep(1); if (++sp > (1u << 24)) break; }
        __builtin_amdgcn_fence(__ATOMIC_ACQUIRE, "agent");
        asm volatile("s_waitcnt vmcnt(0)" ::: "memory");
    }
    __syncthreads();
}
__device__ void phase_ln_res(const Ctx& cx, PRM p, int l, int which, unsigned char* smem) {
    const int wid = cx.tid >> 6, lane = cx.tid & 63;
    const bf16_t* y = (const bf16_t*)(p.big + BIG_Y);
    const float* lg = (which == 0 ? p.ln1_g : p.ln2_g) + l * 1024; const float* lb = (which == 0 ? p.ln1_b : p.ln2_b) + l * 1024;
    const bool first_src = (l == 0 && which == 0);
    const bool want_a1 = !(l == 1 && which == 1);
    int row0 = cx.bid * 8 + wid, row1 = LROWS, rstep = cx.nb * 8;
    if (l == 0) {
        if (cx.bid < 16) {
            const int K = which == 0 ? 1024 : DFF;
            pg8::EpiBf16 E; E.O = (bf16_t*)(p.big + BIG_Y) + (size_t)LROWS * 1024; E.ldc = 1024; E.split_cols = 0; E.split_stride = 0;
            pg8::Gemm g; g.A = (which == 0 ? p.A1 : (const bf16_t*)(p.big + BIG_V)) + (size_t)LROWS * K; g.Bt = which == 0 ? p.WoutT : p.WdownT; g.M = 1024; g.N = 1024; g.K = K;
            pg8::StaticOrder S; S.init(1024, 1024, 16, (int)cx.bid);
            pg8::gemm_phase<pg8::EpiBf16, pg8::StaticOrder>(cx, (LAS unsigned char*)smem, g, S, E);
            sub_barrier(cx, p.bar + 3520 + which * 64, 16u);
            row0 = LROWS + cx.bid * 8 + wid; row1 = MROWS; rstep = 16 * 8;
        } else { row0 = (cx.bid - 16) * 8 + wid; rstep = (cx.nb - 16) * 8; }
    }
    for (int row = row0; row < row1; row += rstep) {
        const float* hs; float* hd;
        if (row < LROWS) { hs = (first_src ? p.x : p.out) + (size_t)row * 1024; hd = p.out + (size_t)row * 1024; }
        else { hs = (first_src ? p.ctx : p.hc) + (size_t)(row - LROWS) * 1024; hd = p.hc + (size_t)(row - LROWS) * 1024; }
        const float* md = p.mod + (size_t)(l * 5 + mod_row(row)) * 6144;
        const float* gate = md + (which == 0 ? 2 : 5) * 1024;
        float v[16];
#pragma unroll
        for (int i = 0; i < 4; ++i) { const int c0 = lane * 4 + 256 * i;
            const f32x4 h4 = *(const f32x4*)(hs + c0), g4 = *(const f32x4*)(gate + c0); const u32x2 yb = *(const u32x2*)(y + (size_t)row * 1024 + c0); const f32x4 y4 = {lo2f(yb.x), hi2f(yb.x), lo2f(yb.y), hi2f(yb.y)};
#pragma unroll
            for (int j = 0; j < 4; ++j) v[i * 4 + j] = ALPHA_C * h4[j] + g4[j] * y4[j]; }
        float mu, rstd; ln_stats16(v, mu, rstd);
#pragma unroll
        for (int i = 0; i < 4; ++i) { const int c0 = lane * 4 + 256 * i;
            const f32x4 g4 = *(const f32x4*)(lg + c0), b4 = *(const f32x4*)(lb + c0); f32x4 o;
#pragma unroll
            for (int j = 0; j < 4; ++j) { o[j] = (v[i * 4 + j] - mu) * rstd * g4[j] + b4[j]; v[i * 4 + j] = o[j]; }
            *(f32x4*)(hd + c0) = o; }
        if (want_a1) {
            const float* md2 = which == 0 ? md : p.mod + (size_t)((l + 1) * 5 + mod_row(row)) * 6144;
            const int si = which == 0 ? 3 : 0;
            store_mod_bf16(p.A1 + (size_t)row * 1024, v, md2 + si * 1024, md2 + (si + 1) * 1024, lane);
        }
    }
}

__device__ __forceinline__ int s5_rowbase(int q) { const int b = q / 528, j = q % 528; return j < 16 ? LROWS + b * 256 + j * 16 : b * 8192 + (j - 16) * 16; }

__device__ void phase_s5a(const Ctx& cx, PRM p, int l, unsigned char* smem, const int b0) {
    const int tid = cx.tid, wid = tid >> 6, lane = tid & 63, fr = lane & 15, fq = lane >> 4;
    const bf16_t* __restrict__ z = (const bf16_t*)(p.big + BIG_Z);
    float* __restrict__ loc = (float*)(p.big + BIG_LOC);
    constexpr int RS = 528;
    for (int bj = cx.bid - b0; bj < 144; bj += cx.nb - b0) {
        const int g = 2 * (bj & 7) + (bj >> 3) / 9, cb = (bj >> 3) % 9;
        const unsigned char* __restrict__ m2 = (const unsigned char*)(p.M2T + (size_t)(l * 16 + g) * 256 * 256);
        __syncthreads();
        { u32x4 st_[16];
#pragma unroll
            for (int k = 0; k < 16; ++k) { const int i = tid + k * NTHR, r = i >> 5, c = i & 31; st_[k] = *(const u32x4*)(m2 + (size_t)r * 512 + c * 16); }
#pragma unroll
            for (int k = 0; k < 16; ++k) { const int i = tid + k * NTHR, r = i >> 5, c = i & 31; *(u32x4*)(smem + r * RS + c * 16) = st_[k]; } }
        __syncthreads();
#pragma unroll 1
        for (int jb = 0; jb < 2; ++jb) {
            const int cgp = cb * 16 + jb * 8 + wid;
            if (cgp < 132) {
                const int rb = s5_rowbase(cgp * 16 + fr);
                bf16x8 a[8];
#pragma unroll
                for (int kk = 0; kk < 8; ++kk) a[kk] = *(const bf16x8*)(z + (size_t)(rb + kk * 2 + (fq >> 1)) * ZLD + ZC_U5 + g * 16 + (fq & 1) * 8);
#pragma unroll 2
                for (int ntl = 0; ntl < 16; ++ntl) {
                    f32x4 acc = {0.f, 0.f, 0.f, 0.f};
#pragma unroll
                    for (int kk = 0; kk < 8; ++kk) { const bf16x8 bb = *(const bf16x8*)(smem + (ntl * 16 + fr) * RS + kk * 64 + fq * 16); acc = mfma16(a[kk], bb, acc); }
                    const int n2 = ntl * 16 + fr, d = n2 >> 7, n = n2 & 127;
#pragma unroll
                    for (int jj = 0; jj < 4; ++jj) { const int q = cgp * 16 + fq * 4 + jj, b = q / 528, j = q % 528;
                        loc[((size_t)((d * 4 + b) * 16 + g) * 528 + j) * 128 + n] = acc[jj]; }
                }
            }
        }
    }
    __syncthreads();
}
__device__ void s5_carry(PRM p, int l, int chain, int lane) {
    const int d = chain >> 6, b = (chain >> 4) & 3, g = chain & 15;
    const float* loc = (const float*)(p.big + BIG_LOC) + (size_t)((d * 4 + b) * 16 + g) * 528 * 128;
    bf16_t* xe = (bf16_t*)(p.big + BIG_XE) + (size_t)(d * 4 + b) * 528 * 16 * 128 + (size_t)g * 128;
    const float* L = p.L16 + ((size_t)((l * 2 + d) * 16 + g) * 64 + lane) * 2;
    const float Lr = L[0], Li = L[1];
    float sr = 0.f, si = 0.f;
    for (int s0 = 0; s0 < 528; s0 += 24) {
        float vr[24], vi[24];
#pragma unroll
        for (int i = 0; i < 24; ++i) { const int s = s0 + i; const int j = d == 0 ? s : (s < 16 ? 15 - s : 543 - s); vr[i] = loc[(size_t)j * 128 + lane]; vi[i] = loc[(size_t)j * 128 + 64 + lane]; }
#pragma unroll
        for (int i = 0; i < 24; ++i) { const int s = s0 + i; const int j = d == 0 ? s : (s < 16 ? 15 - s : 543 - s);
            xe[(size_t)j * 2048 + lane] = f2bf(sr); xe[(size_t)j * 2048 + 64 + lane] = f2bf(si);
            const float nr = Lr * sr - Li * si + vr[i], ni = Lr * si + Li * sr + vi[i]; sr = nr; si = ni; }
    }
}
__device__ void phase_s5c(const Ctx& cx, PRM p, int l, unsigned char* smem) {
    const int tid = cx.tid, wid = tid >> 6, lane = tid & 63, fr = lane & 15, fq = lane >> 4;
    const bf16_t* __restrict__ z = (const bf16_t*)(p.big + BIG_Z);
    const bf16_t* __restrict__ xe = (const bf16_t*)(p.big + BIG_XE);
    bf16_t* __restrict__ g5 = (bf16_t*)(p.big + BIG_G5);
    constexpr int RS = 1040;
    for (int bj = cx.bid; bj < 144; bj += cx.nb) {
        const int g = 2 * (bj & 7) + (bj >> 3) / 9, cb = (bj >> 3) % 9;
        const unsigned char* __restrict__ mc = (const unsigned char*)(p.McatT + (size_t)(l * 16 + g) * 256 * 512);
        const int cg0 = cb * 16 + wid, cg1 = cg0 + 8;
        const bool on0 = cg0 < 132, on1 = cg1 < 132;
        const int qa0 = (on0 ? cg0 : 0) * 16 + fr, qa1 = (on1 ? cg1 : 0) * 16 + fr;
        const int rb0 = s5_rowbase(qa0), rb1 = s5_rowbase(qa1);
        bf16x8 a0[16], a1[16];
#pragma unroll
        for (int kk = 0; kk < 8; ++kk) { a0[kk] = *(const bf16x8*)(z + (size_t)(rb0 + kk * 2 + (fq >> 1)) * ZLD + ZC_U5 + g * 16 + (fq & 1) * 8);
            a1[kk] = *(const bf16x8*)(z + (size_t)(rb1 + kk * 2 + (fq >> 1)) * ZLD + ZC_U5 + g * 16 + (fq & 1) * 8); }
#pragma unroll
        for (int kk = 0; kk < 8; ++kk) { const int d = kk >> 2;
            a0[8 + kk] = *(const bf16x8*)(xe + ((size_t)((d * 4 + qa0 / 528) * 528 + qa0 % 528) * 16 + g) * 128 + (kk & 3) * 32 + fq * 8);
            a1[8 + kk] = *(const bf16x8*)(xe + ((size_t)((d * 4 + qa1 / 528) * 528 + qa1 % 528) * 16 + g) * 128 + (kk & 3) * 32 + fq * 8); }
        bf16_t* orow0 = g5 + (size_t)rb0 * 256 + g * 16 + fq * 4; bf16_t* orow1 = g5 + (size_t)rb1 * 256 + g * 16 + fq * 4;
#pragma unroll 1
        for (int hf = 0; hf < 2; ++hf) {
            __syncthreads();
#pragma unroll 1
            for (int k0 = 0; k0 < 16; k0 += 8) { u32x4 st_[8];
#pragma unroll
                for (int k = 0; k < 8; ++k) { const int i = tid + (k0 + k) * NTHR, r = i >> 6, c = i & 63; st_[k] = *(const u32x4*)(mc + (size_t)(hf * 128 + r) * 1024 + c * 16); }
#pragma unroll
                for (int k = 0; k < 8; ++k) { const int i = tid + (k0 + k) * NTHR, r = i >> 6, c = i & 63; *(u32x4*)(smem + r * RS + c * 16) = st_[k]; } }
            __syncthreads();
#pragma unroll 1
            for (int tt = 0; tt < 8; ++tt) {
                f32x4 acc0 = {0.f, 0.f, 0.f, 0.f}, acc1 = {0.f, 0.f, 0.f, 0.f};
#pragma unroll
                for (int kk = 0; kk < 16; ++kk) { const bf16x8 bb = *(const bf16x8*)(smem + (tt * 16 + fr) * RS + kk * 64 + fq * 16); acc0 = mfma16(bb, a0[kk], acc0); acc1 = mfma16(bb, a1[kk], acc1); }
                const int t = hf * 8 + tt;
                if (on0) { u32x2 w; w.x = pk2(gelu_tanh(acc0[0]), gelu_tanh(acc0[1])); w.y = pk2(gelu_tanh(acc0[2]), gelu_tanh(acc0[3])); *(u32x2*)(orow0 + (size_t)t * 256) = w; }
                if (on1) { u32x2 w; w.x = pk2(gelu_tanh(acc1[0]), gelu_tanh(acc1[1])); w.y = pk2(gelu_tanh(acc1[2]), gelu_tanh(acc1[3])); *(u32x2*)(orow1 + (size_t)t * 256) = w; }
            }
        }
    }
    __syncthreads();
}

#define XB_TMO      128
#define XB_XCNT(j)  (256  + 64 * (j))
#define XB_XSUB(j)  (1280 + 64 * (j))
#define XB_XGEN(j)  (2304 + 64 * (j))
#define XB_TOP      3328
#define XB_TOPGEN   3392
#define XCD_BAR_WORDS 3456
#define XB_SPIN_CAP (1u << 22)
__device__ __forceinline__ unsigned xb_ld(unsigned* p)              { return __hip_atomic_load(p, __ATOMIC_RELAXED, __HIP_MEMORY_SCOPE_AGENT); }
__device__ __forceinline__ unsigned xb_add(unsigned* p, unsigned v) { return __hip_atomic_fetch_add(p, v, __ATOMIC_RELAXED, __HIP_MEMORY_SCOPE_AGENT); }
__device__ __forceinline__ unsigned xb_xcc_id() { return (unsigned)__builtin_amdgcn_s_getreg((3 << 11) | 20) & 0xFu; }
#define XB_SPIN(cond, bar) do { unsigned _sp = 0; while (cond) { __builtin_amdgcn_s_sleep(1); \
    if ((++_sp & 255u) == 0u) { if (xb_ld(&(bar)[XB_TMO])) break; if (_sp > XB_SPIN_CAP) { atomicAdd(&(bar)[XB_TMO], 1u); break; } } } } while (0)
struct XcdBarrier { unsigned* bar; unsigned x; volatile LAS unsigned* st; };
__device__ __forceinline__ XcdBarrier xcd_barrier_post(unsigned* bar, volatile LAS unsigned* st) {
    XcdBarrier b; b.bar = bar; b.x = xb_xcc_id(); b.st = st;
    if (threadIdx.x == 0) (void)xb_add(&bar[XB_XCNT(b.x)], 1u);
    return b;
}
__device__ __forceinline__ void xcd_barrier_complete(unsigned* bar, unsigned x, unsigned& nloc, unsigned& nx) {
    const unsigned G = gridDim.x * gridDim.y * gridDim.z;
    unsigned sum, cnt, mine, sp = 0u;
    for (;;) {
        sum = 0u; cnt = 0u; mine = 0u;
#pragma unroll
        for (unsigned j = 0; j < 16; ++j) { const unsigned c = xb_ld(&bar[XB_XCNT(j)]); sum += c; cnt += (c > 0u) ? 1u : 0u; mine = (j == x) ? c : mine; }
        if (sum == G) break;
        __builtin_amdgcn_s_sleep(1);
        if ((++sp & 255u) == 0u) { if (xb_ld(&bar[XB_TMO])) break; if (sp > XB_SPIN_CAP) { atomicAdd(&bar[XB_TMO], 1u); break; } }
    }
    nloc = mine > 0u ? mine : 1u; nx = cnt > 0u ? cnt : 1u;
}
__device__ __forceinline__ void xcd_barrier(const XcdBarrier& b) {
    asm volatile("s_waitcnt vmcnt(0)" ::: "memory");
    __syncthreads();
    if (threadIdx.x == 0) {
        unsigned* bar = b.bar;
        __builtin_amdgcn_s_waitcnt(0);
        unsigned nloc = b.st[0], nx = b.st[1];
        if (nloc == 0u) { xcd_barrier_complete(bar, b.x, nloc, nx); b.st[0] = nloc; b.st[1] = nx; }
        const unsigned old = xb_add(&bar[XB_XSUB(b.x)], 1u);
        const unsigned gen = old / nloc;
        if (old + 1u == (gen + 1u) * nloc) {
            __builtin_amdgcn_fence(__ATOMIC_RELEASE, "agent");
            asm volatile("s_waitcnt vmcnt(0)" ::: "memory");
            const unsigned og = xb_add(&bar[XB_TOP], 1u);
            const unsigned tg = og / nx;
            if (og + 1u == (tg + 1u) * nx) xb_add(&bar[XB_TOPGEN], 1u);
            else XB_SPIN(xb_ld(&bar[XB_TOPGEN]) == tg, bar);
            __builtin_amdgcn_fence(__ATOMIC_ACQUIRE, "agent");
            xb_add(&bar[XB_XGEN(b.x)], 1u);
            asm volatile("s_waitcnt vmcnt(0)" ::: "memory");
        } else {
            XB_SPIN(xb_ld(&bar[XB_XGEN(b.x)]) == gen, bar);
            __builtin_amdgcn_fence(__ATOMIC_ACQUIRE, "agent");
            asm volatile("s_waitcnt vmcnt(0)" ::: "memory");
        }
    }
    __syncthreads();
}

__device__ __forceinline__ int walk_rowbase(int b, int d, int s) {
    if (d == 0) return s < 4 ? LROWS + b * 256 + s * 64 : b * 8192 + (s - 4) * 64;
    return s < 4 ? LROWS + b * 256 + (3 - s) * 64 : b * 8192 + (131 - s) * 64;
}
constexpr int HALF_LDS = 75 * 1024;

#define LBAR() do { asm volatile("s_waitcnt lgkmcnt(0)" ::: "memory"); __builtin_amdgcn_s_barrier(); asm volatile("" ::: "memory"); } while (0)
#define SCAT8(dst, str, VV_) do { (dst)[0 * (str)] = (bf16_t)((VV_).x & 0xFFFF); (dst)[1 * (str)] = (bf16_t)((VV_).x >> 16); (dst)[2 * (str)] = (bf16_t)((VV_).y & 0xFFFF); (dst)[3 * (str)] = (bf16_t)((VV_).y >> 16); \
        (dst)[4 * (str)] = (bf16_t)((VV_).z & 0xFFFF); (dst)[5 * (str)] = (bf16_t)((VV_).z >> 16); (dst)[6 * (str)] = (bf16_t)((VV_).w & 0xFFFF); (dst)[7 * (str)] = (bf16_t)((VV_).w >> 16); } while (0)
__device__ __forceinline__ float fast_logsig(float x) { return fminf(x, 0.f) - __logf(1.0f + __expf(-fabsf(x))); }
__device__ __forceinline__ int chunk_rowbase(int cgi) { const int b = cgi / 132, j = cgi % 132; return j < 4 ? LROWS + b * 256 + j * 64 : b * 8192 + (j - 4) * 64; }
__device__ __forceinline__ int walk_cgi(int b, int d, int s) { return b * 132 + (d == 0 ? s : (s < 4 ? 3 - s : 135 - s)); }

typedef short s16x4 __attribute__((ext_vector_type(4)));
__device__ __forceinline__ bf16x8 tr_frag(const bf16_t* base, int rs, int c, int ks, int lane) {
    const int g = lane >> 4, q = (lane & 15) >> 2, pp = lane & 3;
    const bf16_t* a0 = base + (32 * ks + 8 * g + q) * rs + 16 * c + 4 * pp;
    const s16x4 v0 = __builtin_amdgcn_ds_read_tr16_b64_v4i16((LAS s16x4*)(a0));
    const s16x4 v1 = __builtin_amdgcn_ds_read_tr16_b64_v4i16((LAS s16x4*)(a0 + 4 * rs));
    return (bf16x8){v0[0], v0[1], v0[2], v0[3], v1[0], v1[1], v1[2], v1[3]};
}

struct GlaPrepIn { u32x4 l0, l1, l2, l3, v[3]; u32x2 q[3], k[3]; };
__device__ __forceinline__ void gla_prep_load(PRM p, int job, int tid, GlaPrepIn& in) {
    const int h = job & 3, d = (job >> 2) & 1, cgi = job >> 3, rbase = chunk_rowbase(cgi);
    const bf16_t* __restrict__ z = (const bf16_t*)(p.big + BIG_Z);
    const int r = tid >> 2, c4 = tid & 3;
    const bf16_t* zr = z + (size_t)(rbase + r) * ZLD;
    in.l0 = *(const u32x4*)(zr + ZC_GLR); in.l1 = *(const u32x4*)(zr + ZC_GLR + 8); in.l2 = *(const u32x4*)(zr + ZC_GLR + 16); in.l3 = *(const u32x4*)(zr + ZC_GLR + 24); (void)d;
#pragma unroll
    for (int i = 0; i < 3; ++i) { in.q[i] = *(const u32x2*)(zr + ZC_GQ + h * 48 + c4 * 12 + i * 4); in.k[i] = *(const u32x2*)(zr + ZC_GK + h * 48 + c4 * 12 + i * 4); }
#pragma unroll
    for (int j = 0; j < 3; ++j) { const int i = tid + 256 * j, ro_ = i / 12, c8 = i % 12; in.v[j] = *(const u32x4*)(z + (size_t)(rbase + ro_) * ZLD + ZC_GV + h * 96 + c8 * 8); }
}
__device__ void gla_prep_job(PRM p, int l, int job, unsigned char* hl, int tid, const GlaPrepIn& in) {
    const int h = job & 3, d = (job >> 2) & 1, cgi = job >> 3, rbase = chunk_rowbase(cgi);
    const int wv = tid >> 6, lane = tid & 63, fr = lane & 15, fq = lane >> 4;
    float* LG = (float*)hl; float* WA = LG + 64 * 49; float* BA = WA + 768;
    bf16_t* QD = (bf16_t*)(hl + 20480);
    bf16_t* KD = QD + 64 * 72;
    bf16_t* ATT = KD + 64 * 72;
    bf16_t* V = ATT + 64 * 72;
    const bf16_t* z = (const bf16_t*)(p.big + BIG_Z);
    bf16_t* QDg = (bf16_t*)((unsigned char*)p.A1 + A1_QD); bf16_t* KDg = (bf16_t*)((unsigned char*)p.A1 + A1_KD); float* BLg = (float*)((unsigned char*)p.A1 + A1_BL);
    bf16_t* ob = (bf16_t*)(p.big + BIG_OBUF) + (size_t)d * MROWS * 768;
    LBAR();
    const int r = tid >> 2, c4 = tid & 3, row = rbase + r, li = d ? 63 - r : r;
    const u32x4 l0 = d ? in.l2 : in.l0, l1 = d ? in.l3 : in.l1;
    WA += d * 816; BA += d * 816;
    u32x2 qv[3], kv[3];
#pragma unroll
    for (int i = 0; i < 3; ++i) { qv[i] = in.q[i]; kv[i] = in.k[i]; }
#pragma unroll
    for (int j = 0; j < 3; ++j) { const int i = tid + 256 * j, ro_ = i / 12, c8 = i % 12;
        *(u32x4*)(V + (d ? 63 - ro_ : ro_) * 104 + c8 * 8) = in.v[j]; }
    LBAR();
    {
        float lr[16];
        lr[0] = lo2f(l0.x); lr[1] = hi2f(l0.x); lr[2] = lo2f(l0.y); lr[3] = hi2f(l0.y); lr[4] = lo2f(l0.z); lr[5] = hi2f(l0.z); lr[6] = lo2f(l0.w); lr[7] = hi2f(l0.w);
        lr[8] = lo2f(l1.x); lr[9] = hi2f(l1.x); lr[10] = lo2f(l1.y); lr[11] = hi2f(l1.y); lr[12] = lo2f(l1.z); lr[13] = hi2f(l1.z); lr[14] = lo2f(l1.w); lr[15] = hi2f(l1.w);
#pragma unroll 4
        for (int kq = 0; kq < 12; ++kq) { const int k = c4 * 12 + kq; float zz = BA[k];
#pragma unroll
            for (int rr = 0; rr < 16; ++rr) zz += lr[rr] * WA[rr * 48 + k];
            LG[li * 49 + k] = fast_logsig(zz) * (1.0f / 16.0f); }
    }
    LBAR();
    if (tid < 48) { float run = 0.f;
#pragma unroll 16
        for (int ss = 0; ss < 64; ++ss) { run += LG[ss * 49 + tid]; LG[ss * 49 + tid] = run; }
        BLg[((size_t)(cgi * 2 + d) * 4 + h) * 48 + tid] = run; }
    LBAR();
    {
        float qf[12], kf[12];
#pragma unroll
        for (int i = 0; i < 3; ++i) { qf[i * 4] = lo2f(qv[i].x); qf[i * 4 + 1] = hi2f(qv[i].x); qf[i * 4 + 2] = lo2f(qv[i].y); qf[i * 4 + 3] = hi2f(qv[i].y);
            kf[i * 4] = lo2f(kv[i].x); kf[i * 4 + 1] = hi2f(kv[i].x); kf[i * 4 + 2] = lo2f(kv[i].y); kf[i * 4 + 3] = hi2f(kv[i].y); }
#pragma unroll
        for (int kq = 0; kq < 12; ++kq) { const float bq = LG[li * 49 + c4 * 12 + kq]; qf[kq] *= __expf(bq); kf[kq] *= __expf(-bq); }
        bf16_t* qo = QDg + ((size_t)row * 2 + d) * 192 + h * 48 + c4 * 12; bf16_t* ko = KDg + ((size_t)row * 2 + d) * 192 + h * 48 + c4 * 12;
#pragma unroll
        for (int i = 0; i < 3; ++i) { u32x2 w; w.x = pk2(qf[i * 4], qf[i * 4 + 1]); w.y = pk2(qf[i * 4 + 2], qf[i * 4 + 3]); *(u32x2*)(qo + i * 4) = w; *(u32x2*)(QD + li * 72 + c4 * 12 + i * 4) = w;
            u32x2 w2; w2.x = pk2(kf[i * 4], kf[i * 4 + 1]); w2.y = pk2(kf[i * 4 + 2], kf[i * 4 + 3]); *(u32x2*)(ko + i * 4) = w2; *(u32x2*)(KD + li * 72 + c4 * 12 + i * 4) = w2; }
    }
    LBAR();
    {
        f32x4 acc[4];
#pragma unroll
        for (int st = 0; st < 4; ++st) acc[st] = (f32x4){0.f, 0.f, 0.f, 0.f};
#pragma unroll
        for (int kk = 0; kk < 2; ++kk) { const bf16x8 a = *(const bf16x8*)(QD + (wv * 16 + fr) * 72 + kk * 32 + fq * 8);
#pragma unroll
            for (int st = 0; st < 4; ++st) if (st <= wv) { const bf16x8 bb = *(const bf16x8*)(KD + (st * 16 + fr) * 72 + kk * 32 + fq * 8); acc[st] = mfma16(a, bb, acc[st]); } }
#pragma unroll
        for (int st = 0; st < 4; ++st) { const int sidx = st * 16 + fr;
#pragma unroll
            for (int jj = 0; jj < 4; ++jj) { const int t = wv * 16 + fq * 4 + jj; const float pv = (st <= wv && sidx <= t) ? acc[st][jj] : 0.f; ATT[t * 72 + sidx] = f2bf(pv); } }
    }
    LBAR();
    {
        const bf16x8 b0 = *(const bf16x8*)(ATT + (wv * 16 + fr) * 72 + fq * 8), b1 = *(const bf16x8*)(ATT + (wv * 16 + fr) * 72 + 32 + fq * 8);
        const int t = wv * 16 + fr; bf16_t* orow = ob + (size_t)(rbase + (d ? 63 - t : t)) * 768 + h * 96 + fq * 4;
#pragma unroll
        for (int vt = 0; vt < 6; ++vt) { f32x4 acc = {0.f, 0.f, 0.f, 0.f};
            acc = mfma16(tr_frag(V, 104, vt, 0, lane), b0, acc); acc = mfma16(tr_frag(V, 104, vt, 1, lane), b1, acc);
            u32x2 w; w.x = pk2(acc[0], acc[1]); w.y = pk2(acc[2], acc[3]); *(u32x2*)(orow + vt * 16) = w; }
    }
}
struct MlPrepIn { u32x4 q[3], k[3], v[3]; bf16_t ig[2], fg[2]; };
__device__ __forceinline__ void ml_prep_load(PRM p, int job, int tid, MlPrepIn& in) {
    const int h = job & 3, d = (job >> 2) & 1, cgi = job >> 3, rbase = chunk_rowbase(cgi);
    const bf16_t* __restrict__ z = (const bf16_t*)(p.big + BIG_Z);
#pragma unroll
    for (int j = 0; j < 3; ++j) { const int i = tid + 256 * j, ro_ = i / 12, c8 = i % 12; const bf16_t* zz = z + (size_t)(rbase + ro_) * ZLD + h * 96 + c8 * 8;
        in.q[j] = *(const u32x4*)(zz + ZC_MQ); in.k[j] = *(const u32x4*)(zz + ZC_MK); in.v[j] = *(const u32x4*)(zz + ZC_MV); }
    in.ig[0] = 0; in.fg[0] = 0; in.ig[1] = 0; in.fg[1] = 0; (void)d;
    if (tid < 64) { const bf16_t* z0 = z + (size_t)(rbase + tid) * ZLD; const bf16_t* z1 = z + (size_t)(rbase + 63 - tid) * ZLD;
        in.ig[0] = z0[ZC_MIG + h]; in.fg[0] = z0[ZC_MFG + h]; in.ig[1] = z1[ZC_MIG + 4 + h]; in.fg[1] = z1[ZC_MFG + 4 + h]; }
}
__device__ void ml_prep_job(PRM p, int l, int job, unsigned char* hl, int tid, const MlPrepIn& in) {
    const int h = job & 3, d = (job >> 2) & 1, cgi = job >> 3, rbase = chunk_rowbase(cgi);
    const int wv = tid >> 6, lane = tid & 63, fr = lane & 15, fq = lane >> 4;
    bf16_t* Q = (bf16_t*)hl;
    bf16_t* Kk = Q + 64 * 104;
    bf16_t* V = Kk + 64 * 104;
    bf16_t* P = V + 64 * 104;
    float* CS = (float*)(P + 64 * 72); float* PM = CS + 64; float* ES = PM + 64;
    const bf16_t* z = (const bf16_t*)(p.big + BIG_Z);
    float* G4 = (float*)((unsigned char*)p.A1 + A1_G4); float* CH = (float*)((unsigned char*)p.A1 + A1_CH); float* DN = (float*)((unsigned char*)p.A1 + A1_DN); float* DIg = (float*)((unsigned char*)p.A1 + A1_DI);
    bf16_t* ob = (bf16_t*)(p.big + BIG_OBUF) + (size_t)d * MROWS * 768;
    LBAR();
#pragma unroll
    for (int j = 0; j < 3; ++j) { const int i = tid + 256 * j, ro_ = i / 12, c8 = i % 12, lo_ = (d ? 63 - ro_ : ro_) * 104 + c8 * 8;
        *(u32x4*)(Q + lo_) = in.q[j]; *(u32x4*)(Kk + lo_) = in.k[j]; *(u32x4*)(V + lo_) = in.v[j]; }
    if (wv == 0) {
        const int row = rbase + (d ? 63 - lane : lane);
        const float ig = bf2f(d ? in.ig[1] : in.ig[0]) + p.ml_i_bias[(l * 2 + d) * 4 + h];
        const float lf = fast_logsig(bf2f(d ? in.fg[1] : in.fg[0]) + p.ml_f_bias[(l * 2 + d) * 4 + h]);
        float F = lf;
#pragma unroll
        for (int o = 1; o < 64; o <<= 1) { const float t = __shfl_up(F, o, 64); if (lane >= o) F += t; }
        const float F_last = __shfl(F, 63, 64);
        const float gg = F_last - F + ig;
        const float m_loc = wave_max(gg);
        const float cs = ig - F;
        float pm = cs;
#pragma unroll
        for (int o = 1; o < 64; o <<= 1) { const float t = __shfl_up(pm, o, 64); if (lane >= o) pm = fmaxf(pm, t); }
        *(f32x4*)(G4 + (((size_t)row * 2 + d) * 4 + h) * 4) = (f32x4){F, cs, pm, gg};
        CS[lane] = cs; PM[lane] = pm; ES[lane] = __expf(gg - m_loc);
        if (lane == 0) { CH[((cgi * 2 + d) * 4 + h) * 2] = F_last; CH[((cgi * 2 + d) * 4 + h) * 2 + 1] = m_loc; }
    }
    LBAR();
    if (tid >= 128 && tid < 224) { const int k = tid - 128; float a0 = 0.f;
#pragma unroll 8
        for (int ss = 0; ss < 64; ++ss) a0 += ES[ss] * bf2f(Kk[ss * 104 + k]);
        DN[((size_t)(cgi * 2 + d) * 4 + h) * 96 + k] = a0; }
    {
        f32x4 acc[4];
#pragma unroll
        for (int st = 0; st < 4; ++st) acc[st] = (f32x4){0.f, 0.f, 0.f, 0.f};
#pragma unroll
        for (int kk = 0; kk < 3; ++kk) { const bf16x8 a = *(const bf16x8*)(Q + (wv * 16 + fr) * 104 + kk * 32 + fq * 8);
#pragma unroll
            for (int st = 0; st < 4; ++st) if (st <= wv) { const bf16x8 bb = *(const bf16x8*)(Kk + (st * 16 + fr) * 104 + kk * 32 + fq * 8); acc[st] = mfma16(a, bb, acc[st]); } }
        float rs[4] = {0.f, 0.f, 0.f, 0.f}, pmt[4];
#pragma unroll
        for (int jj = 0; jj < 4; ++jj) pmt[jj] = PM[wv * 16 + fq * 4 + jj];
#pragma unroll
        for (int st = 0; st < 4; ++st) { const int sidx = st * 16 + fr; const float cs = CS[sidx];
#pragma unroll
            for (int jj = 0; jj < 4; ++jj) { const int t = wv * 16 + fq * 4 + jj;
                float pv = 0.f; if (st <= wv && sidx <= t) pv = __expf(cs - pmt[jj]) * acc[st][jj];
                rs[jj] += pv; P[t * 72 + sidx] = f2bf(pv); } }
#pragma unroll
        for (int jj = 0; jj < 4; ++jj) { float v = rs[jj]; v += __shfl_xor(v, 1, 64); v += __shfl_xor(v, 2, 64); v += __shfl_xor(v, 4, 64); v += __shfl_xor(v, 8, 64);
            if (fr == 0) { const int t = wv * 16 + fq * 4 + jj; DIg[((size_t)(rbase + (d ? 63 - t : t)) * 2 + d) * 4 + h] = v; } }
    }
    LBAR();
    {
        const bf16x8 b0 = *(const bf16x8*)(P + (wv * 16 + fr) * 72 + fq * 8), b1 = *(const bf16x8*)(P + (wv * 16 + fr) * 72 + 32 + fq * 8);
        const int t = wv * 16 + fr; bf16_t* orow = ob + (size_t)(rbase + (d ? 63 - t : t)) * 768 + 384 + h * 96 + fq * 4;
#pragma unroll
        for (int vt = 0; vt < 6; ++vt) { f32x4 acc = {0.f, 0.f, 0.f, 0.f};
            acc = mfma16(tr_frag(V, 104, vt, 0, lane), b0, acc); acc = mfma16(tr_frag(V, 104, vt, 1, lane), b1, acc);
            u32x2 w; w.x = pk2(acc[0], acc[1]); w.y = pk2(acc[2], acc[3]); *(u32x2*)(orow + vt * 16) = w; }
    }
}
__device__ void phase_prep(const Ctx& cx, PRM p, int l, unsigned char* smem) {
    const int tid = cx.tid, half = tid >> 8, t2 = tid & 255;
    unsigned char* hl = smem + half * HALF_LDS;
    const int jp0 = (((cx.bid >> 4) << 3) + (cx.bid & 7)) * 2 + ((cx.bid >> 3) & 1);
    { bf16_t* QD = (bf16_t*)(hl + 20480); LBAR(); for (int i = t2; i < 2 * 64 * 72; i += 256) QD[i] = 0;
        const int h = (jp0 * 2 + half) & 3;
        float* WA = (float*)hl + 64 * 49;
        for (int i = t2; i < 2 * 816; i += 256) { const int d = i / 816, j = i % 816;
            WA[i] = j < 768 ? p.gla_w_a2[((size_t)(l * 2 + d) * 16 + j / 48) * 192 + h * 48 + j % 48] : p.gla_b_a[(l * 2 + d) * 192 + h * 48 + (j - 768)]; } }
    {
        GlaPrepIn nxt; int jp = jp0;
        if (jp < 1056) gla_prep_load(p, ((jp * 2 + half) >> 2) * 8 + ((jp * 2 + half) & 3), t2, nxt);
        while (jp < 1056) { const GlaPrepIn cur = nxt; const int jn = jp + cx.nb; const int jq = jp * 2 + half, jb = (jq >> 2) * 8 + (jq & 3);
            if (jn < 1056) gla_prep_load(p, (((jn * 2 + half) >> 2) * 8) + ((jn * 2 + half) & 3), t2, nxt);
#pragma unroll 1
            for (int d = 0; d < 2; ++d) gla_prep_job(p, l, jb + d * 4, hl, t2, cur);
            jp = jn; }
    }
    {
        MlPrepIn nxt; int jp = jp0;
        if (jp < 1056) ml_prep_load(p, ((jp * 2 + half) >> 2) * 8 + ((jp * 2 + half) & 3), t2, nxt);
        while (jp < 1056) { const MlPrepIn cur = nxt; const int jn = jp + cx.nb; const int jq = jp * 2 + half, jb = (jq >> 2) * 8 + (jq & 3);
            if (jn < 1056) ml_prep_load(p, (((jn * 2 + half) >> 2) * 8) + ((jn * 2 + half) & 3), t2, nxt);
#pragma unroll 1
            for (int d = 0; d < 2; ++d) ml_prep_job(p, l, jb + d * 4, hl, t2, cur);
            jp = jn; }
    }
}

__device__ void mlstm_walk(PRM p, int l, int job, unsigned char* hl, int tid, const int seg, const int mode) {
    const int chain = job / 3, slice = job % 3, d = chain >> 4, b = (chain >> 2) & 3, h = chain & 3;
    const int wv = tid >> 6, lane = tid & 63, fr = lane & 15, fq = lane >> 4;
    bf16_t* Q = (bf16_t*)hl;
    bf16_t* Kk = Q + 64 * 104;
    bf16_t* VW = Kk + 64 * 104;
    bf16_t* CT = VW + 64 * 48;
    float* fa = (float*)(CT + 2 * 32 * 104);
    float* WI = fa; float* RR = fa + 64; float* EM = fa + 128; float* DIQ = fa + 192; float* QN = fa + 256; float* NE = fa + 320; float* SC = fa + 416;
    const bf16_t* z = (const bf16_t*)(p.big + BIG_Z);
    const float* G4 = (const float*)((const unsigned char*)p.A1 + A1_G4); const float* CH = (const float*)((const unsigned char*)p.A1 + A1_CH);
    const float* DN = (const float*)((const unsigned char*)p.A1 + A1_DN); const float* DIg = (const float*)((const unsigned char*)p.A1 + A1_DI);
    bf16_t* ob = (bf16_t*)(p.big + BIG_OBUF) + (size_t)d * MROWS * 768;
    f32x4 cacc[3];
#pragma unroll
    for (int i = 0; i < 3; ++i) cacc[i] = (f32x4){0.f, 0.f, 0.f, 0.f};
    const int vt_s = wv & 1, kt0 = (wv >> 1) * 3;
    const int s_begin = seg * 44, s_end = s_begin + 44;
    float* MLS = (float*)((unsigned char*)p.A1 + A1_MLS); float* MLN = (float*)((unsigned char*)p.A1 + A1_MLN);
    float m_state = (mode == 0 && seg > 0) ? -1e30f : 0.f, f_acc = 0.f, n_reg = 0.f;
    for (int i = tid; i < 2 * 32 * 104; i += 256) CT[i] = 0;
    if (mode == 1) {
        for (int sp = 0; sp < seg; ++sp) {
            const float* sm = MLS + ((size_t)(job * 2 + sp) * 256 + tid) * 12; const float* sn = MLN + (size_t)(job * 2 + sp) * 128;
            const float Fs = sn[97], ms = sn[96];
            const float mn = fmaxf(Fs + m_state, ms), aa = __expf(Fs + m_state - mn), bb2 = __expf(ms - mn);
#pragma unroll
            for (int i = 0; i < 3; ++i) { const f32x4 cs4 = *(const f32x4*)(sm + i * 4); cacc[i] = cacc[i] * aa + cs4 * bb2; }
            if (tid < 96) n_reg = aa * n_reg + bb2 * sn[tid];
            m_state = mn;
        }
        LBAR();
        bf16_t* CT0 = CT + (s_begin & 1) * 32 * 104;
#pragma unroll
        for (int i = 0; i < 3; ++i)
#pragma unroll
            for (int jj = 0; jj < 4; ++jj) CT0[(vt_s * 16 + fq * 4 + jj) * 104 + (kt0 + i) * 16 + fr] = f2bf(cacc[i][jj]);
    }
    if (tid < 96) NE[tid] = n_reg;
    int lo[3], go[3];
#pragma unroll
    for (int j = 0; j < 3; ++j) { const int i = tid + 256 * j, r = i / 12, c8 = i % 12; lo[j] = r * 104 + c8 * 8; go[j] = (d ? 63 - r : r) * ZLD + h * 96 + c8 * 8; }
    const int vr_ = tid >> 2, vc8 = tid & 3, vrow = d ? 63 - vr_ : vr_;
    const int grow = d ? 63 - lane : lane;
    const int trow = d ? 63 - (wv * 16 + fr) : (wv * 16 + fr);
    const int ocol = 384 + h * 96 + slice * 32 + fq * 4;
    u32x4 rq[3], rk[3], rv; f32x4 rg4 = {0.f, 0.f, 0.f, 0.f}; float rgv = 0.f, rfl = 0.f, rml = 0.f, rdn = 0.f, rdi = 0.f; u32x2 ro[2];
#define ML_LOAD(ss) do { const int cgi_ = walk_cgi(b, d, (ss)); const int rb_ = chunk_rowbase(cgi_); const bf16_t* zb = z + (size_t)rb_ * ZLD; \
        _Pragma("unroll") for (int j = 0; j < 3; ++j) { if (mode == 1) rq[j] = *(const u32x4*)(zb + go[j] + ZC_MQ); rk[j] = *(const u32x4*)(zb + go[j] + ZC_MK); } \
        rv = *(const u32x4*)(zb + (size_t)vrow * ZLD + ZC_MV + h * 96 + slice * 32 + vc8 * 8); \
        rgv = G4[(((size_t)(rb_ + vrow) * 2 + d) * 4 + h) * 4 + 3]; rml = CH[((cgi_ * 2 + d) * 4 + h) * 2 + 1]; \
        if (wv == 0) { rg4 = *(const f32x4*)(G4 + (((size_t)(rb_ + grow) * 2 + d) * 4 + h) * 4); rfl = CH[((cgi_ * 2 + d) * 4 + h) * 2]; rdi = DIg[((size_t)(rb_ + grow) * 2 + d) * 4 + h]; } \
        if (tid < 96) rdn = DN[((size_t)(cgi_ * 2 + d) * 4 + h) * 96 + tid]; \
        if (mode == 1) { const bf16_t* op_ = ob + (size_t)(rb_ + trow) * 768 + ocol; ro[0] = *(const u32x2*)(op_); ro[1] = *(const u32x2*)(op_ + 16); } } while (0)
    for (int j = 0; j < 3; ++j) rq[j] = (u32x4){0u, 0u, 0u, 0u};
    ro[0] = (u32x2){0u, 0u}; ro[1] = (u32x2){0u, 0u};
    ML_LOAD(s_begin);
    for (int s = s_begin; s < s_end; ++s) {
        const int rbase = chunk_rowbase(walk_cgi(b, d, s));
        bf16_t* CTc = CT + (s & 1) * 32 * 104; bf16_t* CTn = CT + ((s + 1) & 1) * 32 * 104;
        LBAR();
#pragma unroll
        for (int j = 0; j < 3; ++j) { if (mode == 1) *(u32x4*)(Q + lo[j]) = rq[j]; *(u32x4*)(Kk + lo[j]) = rk[j]; }
        { const float er = __expf(rgv - rml); u32x4 w;
            w.x = pk2(lo2f(rv.x) * er, hi2f(rv.x) * er); w.y = pk2(lo2f(rv.y) * er, hi2f(rv.y) * er); w.z = pk2(lo2f(rv.z) * er, hi2f(rv.z) * er); w.w = pk2(lo2f(rv.w) * er, hi2f(rv.w) * er);
            *(u32x4*)(VW + vr_ * 48 + vc8 * 8) = w; }
        const float dn_cur = rdn;
        float oin[8];
        oin[0] = lo2f(ro[0].x); oin[1] = hi2f(ro[0].x); oin[2] = lo2f(ro[0].y); oin[3] = hi2f(ro[0].y); oin[4] = lo2f(ro[1].x); oin[5] = hi2f(ro[1].x); oin[6] = lo2f(ro[1].y); oin[7] = hi2f(ro[1].y);
        if (wv == 0) {
            const float F = rg4[0], pm = rg4[2];
            const float mx = fmaxf(m_state, pm);
            const float m_new_ = fmaxf(rfl + m_state, rml);
            WI[lane] = __expf(m_state - mx); RR[lane] = __expf(pm - mx); EM[lane] = __expf(-(F + mx)); DIQ[lane] = rdi;
            if (lane == 0) { SC[0] = __expf(rfl + m_state - m_new_); SC[1] = m_new_; SC[2] = __expf(rml - m_new_); }
            f_acc += rfl;
        }
        if (s + 1 < s_end) ML_LOAD(s + 1);
        LBAR();
        const float alpha = SC[0], m_new = SC[1], beta = SC[2];
        if (mode == 1) {
            const int t = tid >> 2, part = tid & 3; float sacc = 0.f;
#pragma unroll
            for (int k8 = 0; k8 < 3; ++k8) { const u32x4 qv = *(const u32x4*)(Q + t * 104 + part * 24 + k8 * 8); const f32x4 n0 = *(const f32x4*)(NE + part * 24 + k8 * 8), n1 = *(const f32x4*)(NE + part * 24 + k8 * 8 + 4);
                sacc += lo2f(qv.x) * n0[0] + hi2f(qv.x) * n0[1] + lo2f(qv.y) * n0[2] + hi2f(qv.y) * n0[3] + lo2f(qv.z) * n1[0] + hi2f(qv.z) * n1[1] + lo2f(qv.w) * n1[2] + hi2f(qv.w) * n1[3]; }
            sacc += __shfl_xor(sacc, 1, 64); sacc += __shfl_xor(sacc, 2, 64);
            if (part == 0) QN[t] = sacc; }
        __builtin_amdgcn_s_setprio(1);
        f32x4 a1[2];
#pragma unroll
        for (int vt = 0; vt < 2; ++vt) a1[vt] = (f32x4){0.f, 0.f, 0.f, 0.f};
        if (mode == 1)
#pragma unroll
        for (int kk = 0; kk < 3; ++kk) { const bf16x8 bq = *(const bf16x8*)(Q + (wv * 16 + fr) * 104 + kk * 32 + fq * 8);
#pragma unroll
            for (int vt = 0; vt < 2; ++vt) { const bf16x8 ac = *(const bf16x8*)(CTc + (vt * 16 + fr) * 104 + kk * 32 + fq * 8); a1[vt] = mfma16(ac, bq, a1[vt]); } }
        {
            const bf16x8 av0 = tr_frag(VW, 48, vt_s, 0, lane), av1 = tr_frag(VW, 48, vt_s, 1, lane);
#pragma unroll
            for (int i = 0; i < 3; ++i) { f32x4 tacc = {0.f, 0.f, 0.f, 0.f};
                tacc = mfma16(av0, tr_frag(Kk, 104, kt0 + i, 0, lane), tacc); tacc = mfma16(av1, tr_frag(Kk, 104, kt0 + i, 1, lane), tacc);
                cacc[i] = cacc[i] * alpha + tacc * beta;
#pragma unroll
                for (int jj = 0; jj < 4; ++jj) CTn[(vt_s * 16 + fq * 4 + jj) * 104 + (kt0 + i) * 16 + fr] = f2bf(cacc[i][jj]); }
        }
        __builtin_amdgcn_s_setprio(0);
        if (mode == 1) LBAR();
        if (mode == 1) { const int t = wv * 16 + fr; const float wi = WI[t], rr = RR[t];
            const float den = wi * QN[t] + rr * DIQ[t]; const float dnm = fmaxf(fabsf(den), EM[t]); const float inv = __builtin_amdgcn_rcpf(dnm);
            bf16_t* op = ob + (size_t)(rbase + trow) * 768 + ocol;
#pragma unroll
            for (int vt = 0; vt < 2; ++vt) { u32x2 w;
                w.x = pk2((wi * a1[vt][0] + rr * oin[vt * 4 + 0]) * inv, (wi * a1[vt][1] + rr * oin[vt * 4 + 1]) * inv);
                w.y = pk2((wi * a1[vt][2] + rr * oin[vt * 4 + 2]) * inv, (wi * a1[vt][3] + rr * oin[vt * 4 + 3]) * inv);
                *(u32x2*)(op + vt * 16) = w; } }
        if (tid < 96) NE[tid] = alpha * NE[tid] + beta * dn_cur;
        m_state = m_new;
    }
    if (mode == 0) {
        LBAR();
        float* sm = MLS + ((size_t)(job * 2 + seg) * 256 + tid) * 12; float* sn = MLN + (size_t)(job * 2 + seg) * 128;
#pragma unroll
        for (int i = 0; i < 3; ++i) *(f32x4*)(sm + i * 4) = cacc[i];
        if (tid < 96) sn[tid] = NE[tid];
        if (tid == 0) { sn[96] = m_state; sn[97] = f_acc; }
    }
#undef ML_LOAD
}

__device__ void gla_walk(PRM p, int l, int job, unsigned char* hl, int tid, const int seg, const int mode) {
    const int chain = job / 3, slice = job % 3, d = chain >> 4, b = (chain >> 2) & 3, h = chain & 3;
    const int wv = tid >> 6, lane = tid & 63, fr = lane & 15, fq = lane >> 4;
    bf16_t* QD = (bf16_t*)hl;
    bf16_t* KD = QD + 64 * 72;
    bf16_t* V = KD + 64 * 72;
    bf16_t* ST = V + 64 * 48;
    float* BL = (float*)(ST + 2 * 32 * 72);
    const bf16_t* z = (const bf16_t*)(p.big + BIG_Z);
    const bf16_t* QDg = (const bf16_t*)((const unsigned char*)p.A1 + A1_QD); const bf16_t* KDg = (const bf16_t*)((const unsigned char*)p.A1 + A1_KD); const float* BLg = (const float*)((const unsigned char*)p.A1 + A1_BL);
    bf16_t* ob = (bf16_t*)(p.big + BIG_OBUF) + (size_t)d * MROWS * 768;
    for (int i = tid; i < 2 * 64 * 72; i += 256) QD[i] = 0;
    for (int i = tid; i < 2 * 32 * 72; i += 256) ST[i] = 0;
    f32x4 sacc[2];
    sacc[0] = (f32x4){0.f, 0.f, 0.f, 0.f}; sacc[1] = (f32x4){0.f, 0.f, 0.f, 0.f};
    const int vt_s = wv & 1, kt0 = (wv >> 1) * 2, nkt = (wv >> 1) == 0 ? 2 : 1;
    const int s_begin = seg * 66, s_end = s_begin + 66;
    float* GLS = (float*)((unsigned char*)p.A1 + A1_GLS) + ((size_t)job * 256 + tid) * 8;
    if (mode == 1 && seg == 1) {
        sacc[0] = *(const f32x4*)(GLS); sacc[1] = *(const f32x4*)(GLS + 4);
        LBAR();
        bf16_t* ST0 = ST + (s_begin & 1) * 32 * 72;
#pragma unroll
        for (int i = 0; i < 2; ++i) if (i < nkt) {
#pragma unroll
            for (int jj = 0; jj < 4; ++jj) ST0[(vt_s * 16 + fq * 4 + jj) * 72 + (kt0 + i) * 16 + fr] = f2bf(sacc[i][jj]); }
    }
    int lo[3]; size_t go[3]; const bf16_t* gsrc[3];
#pragma unroll
    for (int j = 0; j < 3; ++j) { const int i = tid + 256 * j, wh = i / 384, ii = i % 384, r = ii / 6, c8 = ii % 6;
        lo[j] = wh * 64 * 72 + r * 72 + c8 * 8; go[j] = ((size_t)(d ? 63 - r : r) * 2 + d) * 192 + h * 48 + c8 * 8; gsrc[j] = wh ? KDg : QDg; }
    const int vr_ = tid >> 2, vc8 = tid & 3, vrow = d ? 63 - vr_ : vr_;
    const int trow = d ? 63 - (wv * 16 + fr) : (wv * 16 + fr);
    const int ocol = h * 96 + slice * 32 + fq * 4;
    u32x4 rqk[3], rv; float rbl = 0.f; u32x2 ro[2];
#define GL_LOAD(ss) do { const int cgi_ = walk_cgi(b, d, (ss)); const int rb_ = chunk_rowbase(cgi_); \
        _Pragma("unroll") for (int j = 0; j < 3; ++j) if (mode == 1 || lo[j] >= 64 * 72) rqk[j] = *(const u32x4*)(gsrc[j] + (size_t)rb_ * 384 + go[j]); \
        rv = *(const u32x4*)(z + (size_t)(rb_ + vrow) * ZLD + ZC_GV + h * 96 + slice * 32 + vc8 * 8); \
        if (tid < 48) rbl = BLg[((size_t)(cgi_ * 2 + d) * 4 + h) * 48 + tid]; \
        if (mode == 1) { const bf16_t* op_ = ob + (size_t)(rb_ + trow) * 768 + ocol; ro[0] = *(const u32x2*)(op_); ro[1] = *(const u32x2*)(op_ + 16); } } while (0)
    for (int j = 0; j < 3; ++j) rqk[j] = (u32x4){0u, 0u, 0u, 0u};
    ro[0] = (u32x2){0u, 0u}; ro[1] = (u32x2){0u, 0u};
    GL_LOAD(s_begin);
    for (int s = s_begin; s < s_end; ++s) {
        const int rbase = chunk_rowbase(walk_cgi(b, d, s));
        bf16_t* STc = ST + (s & 1) * 32 * 72; bf16_t* STn = ST + ((s + 1) & 1) * 32 * 72;
        LBAR();
#pragma unroll
        for (int j = 0; j < 3; ++j) if (mode == 1 || lo[j] >= 64 * 72) *(u32x4*)(QD + lo[j]) = rqk[j];
        *(u32x4*)(V + vr_ * 48 + vc8 * 8) = rv;
        if (tid < 48) BL[tid] = rbl;
        float oin[8];
        oin[0] = lo2f(ro[0].x); oin[1] = hi2f(ro[0].x); oin[2] = lo2f(ro[0].y); oin[3] = hi2f(ro[0].y); oin[4] = lo2f(ro[1].x); oin[5] = hi2f(ro[1].x); oin[6] = lo2f(ro[1].y); oin[7] = hi2f(ro[1].y);
        if (s + 1 < s_end) GL_LOAD(s + 1);
        LBAR();
        __builtin_amdgcn_s_setprio(1);
        if (mode == 1) {
            f32x4 a1[2];
#pragma unroll
            for (int vt = 0; vt < 2; ++vt) a1[vt] = (f32x4){0.f, 0.f, 0.f, 0.f};
#pragma unroll
            for (int kk = 0; kk < 2; ++kk) { const bf16x8 bq = *(const bf16x8*)(QD + (wv * 16 + fr) * 72 + kk * 32 + fq * 8);
#pragma unroll
                for (int vt = 0; vt < 2; ++vt) { const bf16x8 as = *(const bf16x8*)(STc + (vt * 16 + fr) * 72 + kk * 32 + fq * 8); a1[vt] = mfma16(as, bq, a1[vt]); } }
            bf16_t* op = ob + (size_t)(rbase + trow) * 768 + ocol;
#pragma unroll
            for (int vt = 0; vt < 2; ++vt) { u32x2 w; w.x = pk2(a1[vt][0] + oin[vt * 4 + 0], a1[vt][1] + oin[vt * 4 + 1]); w.y = pk2(a1[vt][2] + oin[vt * 4 + 2], a1[vt][3] + oin[vt * 4 + 3]); *(u32x2*)(op + vt * 16) = w; }
        }
        {
            const bf16x8 av0 = tr_frag(V, 48, vt_s, 0, lane), av1 = tr_frag(V, 48, vt_s, 1, lane);
#pragma unroll
            for (int i = 0; i < 2; ++i) if (i < nkt) { const int kt = kt0 + i;
                sacc[i] = mfma16(av0, tr_frag(KD, 72, kt, 0, lane), sacc[i]); sacc[i] = mfma16(av1, tr_frag(KD, 72, kt, 1, lane), sacc[i]);
                sacc[i] *= __expf(BL[kt * 16 + fr]);
#pragma unroll
                for (int jj = 0; jj < 4; ++jj) STn[(vt_s * 16 + fq * 4 + jj) * 72 + kt * 16 + fr] = f2bf(sacc[i][jj]); }
        }
        __builtin_amdgcn_s_setprio(0);
    }
    if (mode == 0) { *(f32x4*)(GLS) = sacc[0]; *(f32x4*)(GLS + 4) = sacc[1]; }
#undef GL_LOAD
}

__device__ void phase_walks(const Ctx& cx, PRM p, int l, unsigned char* smem, int pass) {
    const int blk = cx.bid, tid = cx.tid, half = tid >> 8;
    unsigned char* hl = smem + half * HALF_LDS;
    int mixer = -1, rb = 0;
    if (pass == 0) { if (blk < 96) { mixer = 1; rb = blk; } else if (blk < 144) { mixer = 0; rb = blk - 96; } else mixer = 4; }
    else { if (blk < 144) { mixer = 1; rb = blk; } else if (blk < 240) { mixer = 0; rb = blk - 144; } else mixer = 2; }
    const int slot = 2 * (rb >> 3) + half, pr = (slot / 3) * 8 + (rb & 7);
    const int job = (pr & 31) * 3 + slot % 3, seg = pr >> 5;
    if (mixer == 1) mlstm_walk(p, l, job, hl, tid & 255, seg, pass);
    else if (mixer == 0) gla_walk(p, l, job, hl, tid & 255, seg, pass);
    else if (mixer == 2) { const int w = (blk - 240) * 8 + (tid >> 6); if (w < 128) s5_carry(p, l, w, tid & 63); }
    else if (mixer == 4) { Ctx c2 = cx; asm volatile("" : "+v"(c2.tid)); phase_s5a(c2, p, l, smem, 144); }
}

struct PostIn { u32x2 a[3], b[3], g[3]; };
__device__ __forceinline__ void post_load(PRM p, int row, int lane, PostIn& in) {
    const bf16_t* __restrict__ z = (const bf16_t*)(p.big + BIG_Z);
    const bf16_t* __restrict__ of = (const bf16_t*)(p.big + BIG_OBUF) + (size_t)row * 768 + lane * 12;
    const bf16_t* __restrict__ obk = of + (size_t)MROWS * 768;
    const bf16_t* __restrict__ gt = z + (size_t)row * ZLD + (lane >= 32 ? ZC_MO : ZC_GR) + (lane & 31) * 12;
#pragma unroll
    for (int i = 0; i < 3; ++i) { in.a[i] = *(const u32x2*)(of + i * 4); in.b[i] = *(const u32x2*)(obk + i * 4); in.g[i] = *(const u32x2*)(gt + i * 4); }
}
__device__ __forceinline__ void post_finish(PRM p, int l, int row, int lane, const PostIn& in) {
    float v[12];
#pragma unroll
    for (int i = 0; i < 3; ++i) { const u32x2 a = in.a[i], b = in.b[i];
        v[i * 4 + 0] = lo2f(a.x) + lo2f(b.x); v[i * 4 + 1] = hi2f(a.x) + hi2f(b.x); v[i * 4 + 2] = lo2f(a.y) + lo2f(b.y); v[i * 4 + 3] = hi2f(a.y) + hi2f(b.y); }
    float s = 0.f;
#pragma unroll
    for (int i = 0; i < 12; ++i) s += v[i];
    s += __shfl_xor(s, 1, 64); s += __shfl_xor(s, 2, 64); s += __shfl_xor(s, 4, 64);
    const float mu = s * (1.0f / 96.0f);
    float q = 0.f;
#pragma unroll
    for (int i = 0; i < 12; ++i) { const float dd = v[i] - mu; q += dd * dd; }
    q += __shfl_xor(q, 1, 64); q += __shfl_xor(q, 2, 64); q += __shfl_xor(q, 4, 64);
    const float rstd = rsqrtf(q * (1.0f / 96.0f) + 1e-5f);
    const bool isml = lane >= 32;
    const int c0 = (lane & 31) * 12;
    const float* gw = (isml ? p.ml_g : p.gla_g) + l * 384 + c0;
    bf16_t* dst = p.A1 + (size_t)row * 1024 + 256 + lane * 12;
#pragma unroll
    for (int i = 0; i < 3; ++i) { const u32x2 gv = in.g[i];
        float gg[4] = {lo2f(gv.x), hi2f(gv.x), lo2f(gv.y), hi2f(gv.y)}; float o[4];
#pragma unroll
        for (int j = 0; j < 4; ++j) { const float gate = isml ? sigmoidf_(gg[j]) : siluf_(gg[j]); o[j] = gate * ((v[i * 4 + j] - mu) * rstd * gw[i * 4 + j]); }
        u32x2 w; w.x = pk2(o[0], o[1]); w.y = pk2(o[2], o[3]); *(u32x2*)(dst + i * 4) = w; }
}
__device__ void phase_s5c_post(const Ctx& cx, PRM p, int l, unsigned char* smem) {
    const int wid = cx.tid >> 6, lane = cx.tid & 63;
    phase_s5c(cx, p, l, smem);
    {
        constexpr int POST_SPLIT = 22528;
        const bool free_wg = cx.bid >= 144;
        const int lo_ = free_wg ? 0 : POST_SPLIT, hi_ = free_wg ? POST_SPLIT : MROWS;
        const int step_ = (free_wg ? (cx.nb - 144) : 144) * 8;
        int row = lo_ + (free_wg ? cx.bid - 144 : cx.bid) * 8 + wid; PostIn cur, nxt;
        if (row < hi_) post_load(p, row, lane, cur);
        while (row < hi_) { const int rn = row + step_; if (rn < hi_) post_load(p, rn, lane, nxt); post_finish(p, l, row, lane, cur); cur = nxt; row = rn; }
    }
}


__device__ void phase_glu(const Ctx& cx, PRM p, int l, unsigned char* smem) {
    const int tid = cx.tid, wid = tid >> 6, lane = tid & 63, fr = lane & 15, fq = lane >> 4;
    const bf16_t* __restrict__ g5 = (const bf16_t*)(p.big + BIG_G5);
    const unsigned char* __restrict__ wg = (const unsigned char*)(p.WgluT + (size_t)l * 256 * 256);
    const float* __restrict__ bias = p.s5_b_glu + l * 256;
    bf16_t* __restrict__ A1 = p.A1;
    constexpr int RS = 528;
    __syncthreads();
    { u32x4 st_[16];
#pragma unroll
        for (int k = 0; k < 16; ++k) { const int i = tid + k * NTHR, r = i >> 5, c = i & 31; st_[k] = *(const u32x4*)(wg + (size_t)r * 512 + c * 16); }
#pragma unroll
        for (int k = 0; k < 16; ++k) { const int i = tid + k * NTHR, r = i >> 5, c = i & 31; *(u32x4*)(smem + r * RS + c * 16) = st_[k]; } }
    __syncthreads();
    for (int job = cx.bid * 8 + wid; job < MROWS / 16; job += cx.nb * 8) {
        const int row = job * 16 + fr;
        const bf16_t* gr = g5 + (size_t)row * 256;
        bf16x8 a[8]; u32x2 yv[16];
#pragma unroll
        for (int kk = 0; kk < 8; ++kk) a[kk] = *(const bf16x8*)(gr + kk * 32 + fq * 8);
#pragma unroll
        for (int n = 0; n < 16; ++n) yv[n] = *(const u32x2*)(gr + n * 16 + fq * 4);
#pragma unroll
        for (int ntl = 0; ntl < 16; ++ntl) {
            const f32x4 bs = *(const f32x4*)(bias + ntl * 16 + fq * 4);
            f32x4 acc = {0.f, 0.f, 0.f, 0.f};
#pragma unroll
            for (int kk = 0; kk < 8; ++kk) { const bf16x8 b = *(const bf16x8*)(smem + (ntl * 16 + fr) * RS + kk * 64 + fq * 16); acc = mfma16(b, a[kk], acc); }
            const u32x2 y2 = yv[ntl];
            u32x2 w; w.x = pk2(lo2f(y2.x) * sigmoidf_(acc[0] + bs[0]), hi2f(y2.x) * sigmoidf_(acc[1] + bs[1])); w.y = pk2(lo2f(y2.y) * sigmoidf_(acc[2] + bs[2]), hi2f(y2.y) * sigmoidf_(acc[3] + bs[3]));
            *(u32x2*)(A1 + (size_t)row * 1024 + ntl * 16 + fq * 4) = w;
            asm volatile("" ::: "memory");
        }
    }
    __syncthreads();
}

__device__ __forceinline__ void unpack8(const u32x4 w, float (&f)[8]) { f[0] = lo2f(w.x); f[1] = hi2f(w.x); f[2] = lo2f(w.y); f[3] = hi2f(w.y); f[4] = lo2f(w.z); f[5] = hi2f(w.z); f[6] = lo2f(w.w); f[7] = hi2f(w.w); }
__device__ void phase_conv(const Ctx& cx, PRM p, int l) {
    const bf16_t* a = (const bf16_t*)(p.big + BIG_A);
    bf16_t* vg = (bf16_t*)(p.big + BIG_V);
    const float* wd = p.w_dconv + (size_t)l * 9 * DFF; const float* bd = p.b_dconv + (size_t)l * DFF;
    const int nseg = (l == 1) ? 1024 : 1056;
    const long total = (long)nseg * 352;
    for (long it = (long)cx.bid * NTHR + cx.tid; it < total; it += (long)cx.nb * NTHR) {
        const int seg = (int)(it / 352), c0 = (int)(it % 352) * 8;
        int base, x0, W; bool up, dn;
        if (seg < 1024) { base = seg * 32; x0 = (seg & 1) * 32; W = 64; const int y = (seg >> 1) & 127; up = y > 0; dn = y < 127; }
        else { const int sc = seg - 1024; base = LROWS + sc * 32; x0 = (sc & 7) * 32; W = 256; up = false; dn = false; }
        float wgt[9][8], bias[8];
#pragma unroll
        for (int t = 0; t < 9; ++t) { const f32x4 w0 = *(const f32x4*)(wd + t * DFF + c0), w1 = *(const f32x4*)(wd + t * DFF + c0 + 4);
            wgt[t][0] = w0[0]; wgt[t][1] = w0[1]; wgt[t][2] = w0[2]; wgt[t][3] = w0[3]; wgt[t][4] = w1[0]; wgt[t][5] = w1[1]; wgt[t][6] = w1[2]; wgt[t][7] = w1[3]; }
        { const f32x4 b0 = *(const f32x4*)(bd + c0), b1 = *(const f32x4*)(bd + c0 + 4); bias[0] = b0[0]; bias[1] = b0[1]; bias[2] = b0[2]; bias[3] = b0[3]; bias[4] = b1[0]; bias[5] = b1[1]; bias[6] = b1[2]; bias[7] = b1[3]; }
        const u32x4 zero4 = {0u, 0u, 0u, 0u};
        const bf16_t* __restrict__ ac = a + (size_t)base * DFF + c0;
        bf16_t* __restrict__ vp = vg + (size_t)base * DFF + c0;
        u32x4 win[3][3], pre[3];
#pragma unroll
        for (int r = 0; r < 3; ++r) win[0][r] = zero4;
        if (x0 > 0) { win[0][1] = *(const u32x4*)(ac - (size_t)DFF); if (up) win[0][0] = *(const u32x4*)(ac - (size_t)65 * DFF); if (dn) win[0][2] = *(const u32x4*)(ac + (size_t)63 * DFF); }
        win[1][0] = up ? *(const u32x4*)(ac - (size_t)64 * DFF) : zero4; win[1][1] = *(const u32x4*)(ac); win[1][2] = dn ? *(const u32x4*)(ac + (size_t)64 * DFF) : zero4;
        { const bool h1 = (x0 + 1) < W; const bf16_t* a1 = ac + (size_t)DFF;
            win[2][0] = (h1 && up) ? *(const u32x4*)(a1 - (size_t)64 * DFF) : zero4; win[2][1] = h1 ? *(const u32x4*)(a1) : zero4; win[2][2] = (h1 && dn) ? *(const u32x4*)(a1 + (size_t)64 * DFF) : zero4; }
        u32x4 vcur = *(const u32x4*)(vp), vnxt = zero4;
        for (int i = 0; i < 32; ++i) {
            const bool has2 = (x0 + i + 2) < W;
            const bf16_t* an = ac + (size_t)(i + 2) * DFF;
            pre[0] = (has2 && up) ? *(const u32x4*)(an - (size_t)64 * DFF) : zero4;
            pre[1] = has2 ? *(const u32x4*)(an) : zero4;
            pre[2] = (has2 && dn) ? *(const u32x4*)(an + (size_t)64 * DFF) : zero4;
            if (i + 1 < 32) vnxt = *(const u32x4*)(vp + (size_t)(i + 1) * DFF);
            float acc[8];
#pragma unroll
            for (int e = 0; e < 8; ++e) acc[e] = bias[e];
#pragma unroll
            for (int r = 0; r < 3; ++r)
#pragma unroll
                for (int cdx = 0; cdx < 3; ++cdx) { float f[8]; unpack8(win[cdx][r], f);
#pragma unroll
                    for (int e = 0; e < 8; ++e) acc[e] += f[e] * wgt[r * 3 + cdx][e]; }
            float vf[8]; unpack8(vcur, vf);
            u32x4 o;
            o.x = pk2(gelu_tanh(acc[0]) * vf[0], gelu_tanh(acc[1]) * vf[1]); o.y = pk2(gelu_tanh(acc[2]) * vf[2], gelu_tanh(acc[3]) * vf[3]);
            o.z = pk2(gelu_tanh(acc[4]) * vf[4], gelu_tanh(acc[5]) * vf[5]); o.w = pk2(gelu_tanh(acc[6]) * vf[6], gelu_tanh(acc[7]) * vf[7]);
            *(u32x4*)(vp + (size_t)i * DFF) = o;
#pragma unroll
            for (int r = 0; r < 3; ++r) { win[0][r] = win[1][r]; win[1][r] = win[2][r]; win[2][r] = pre[r]; }
            vcur = vnxt;
        }
    }
}

__device__ void run_phase(const Ctx& cx, PRM p, int ph, unsigned char* smem, const XcdBarrier& xb) {
    if (ph == 0) { phase0(cx, p, smem); return; }
    const int l = (ph - 1) / 12, q = (ph - 1) % 12;
    switch (q) {
        case 0: if (l == 0) phase_ln_first(cx, p); break;
        case 1: { pg8::EpiBf16 E; E.O = (bf16_t*)(p.big + BIG_Z); E.ldc = ZLD; E.split_cols = 0; E.split_stride = 0;
            run_gemm(cx, smem, p.A1, p.WinT + (size_t)l * 3072 * 1024, MROWS, 3072, 1024, E); } break;
        case 2: phase_prep(cx, p, l, smem); break;
        case 3:
#pragma unroll 1
            for (int pass = 0; pass < 2; ++pass) {
#if COOP
                if (pass) xcd_barrier(xb);
#endif
                phase_walks(cx, p, l, smem, pass); }
            break;
        case 4: phase_s5c_post(cx, p, l, smem); break;
        case 5: phase_glu(cx, p, l, smem); break;
        case 6: { pg8::EpiBf16 E; E.O = (bf16_t*)(p.big + BIG_Y); E.ldc = 1024; E.split_cols = 0; E.split_stride = 0;
            run_gemm(cx, smem, p.A1, p.WoutT + (size_t)l * 1024 * 1024, LROWS, 1024, 1024, E); } break;
        case 7: phase_ln_res(cx, p, l, 0, smem); break;
        case 8: { pg8::EpiBf16 E; E.O = (bf16_t*)(p.big + BIG_A); E.ldc = DFF; E.split_cols = DFF; E.split_stride = (size_t)MROWS * DFF;
            run_gemm(cx, smem, p.A1, p.WupT + (size_t)l * 5632 * 1024, l == 1 ? LROWS : MROWS, 5632, 1024, E); } break;
        case 9: phase_conv(cx, p, l); break;
        case 10: { pg8::EpiBf16 E; E.O = (bf16_t*)(p.big + BIG_Y); E.ldc = 1024; E.split_cols = 0; E.split_stride = 0;
            run_gemm(cx, smem, (const bf16_t*)(p.big + BIG_V), p.WdownT + (size_t)l * 1024 * DFF, LROWS, 1024, DFF, E); } break;
        case 11: phase_ln_res(cx, p, l, 1, smem); break;
    }
}

__global__ void __launch_bounds__(512, 2) mega(Params p) {
    extern __shared__ __attribute__((aligned(16))) unsigned char smem[];
    bool first = true;
    XcdBarrier xb{};
#if COOP
    volatile LAS unsigned* xst = (volatile LAS unsigned*)(LAS unsigned char*)(smem + LDS_MAIN);
    if (threadIdx.x == 0) { xst[0] = 0u; xst[1] = 0u; }
    __syncthreads();
    xb = xcd_barrier_post(p.bar, xst);
#endif
#ifndef PROBE_DUP
#define PROBE_DUP 0
#endif
    int ph = p.ph_lo, rep = 0;
    while (ph < p.ph_hi) {
        if (ph == 13) { ++ph; continue; }
#if COOP
        if (!first) { if (p.ph_hi > 1000) cg::this_grid().sync(); else xcd_barrier(xb); }
#endif
        first = false;
        Ctx cx; { int t_ = threadIdx.x, b_ = blockIdx.x, n_ = gridDim.x; asm volatile("" : "+v"(t_)); asm volatile("" : "+s"(b_)); asm volatile("" : "+s"(n_)); cx.tid = t_; cx.bid = b_; cx.nb = n_; }
        const __attribute__((address_space(4))) Params* kp = (const __attribute__((address_space(4))) Params*)__builtin_amdgcn_kernarg_segment_ptr();
        asm volatile("" : "+s"(kp));
        run_phase(cx, *kp, ph, smem, xb);
        const int q_ = ph == 0 ? 12 : (ph - 1) % 12;
        const bool again = PROBE_DUP != 0 && rep == 0 && ((PROBE_DUP >> q_) & 1) && (ph <= 12 || !((PROBE_DUP >> 13) & 1));
        if (again) rep = 1; else { rep = 0; ++ph; }
    }
}

extern "C" void kernel_launch(void* const* d_in, const int* in_sizes, int n_in, void* d_out, int out_size, void* d_ws, size_t ws_size, hipStream_t stream) {
    static int grid = 0;
    if (grid == 0) {
        if (n_in != 32 || ws_size < WS_END) { fprintf(stderr, "kernel_launch: need 32 inputs and %zu bytes of workspace (got %d, %zu)\n", (size_t)WS_END, n_in, ws_size); grid = -1; return; }
        int dev = 0, cus = 0, per_cu = 0;
        (void)hipGetDevice(&dev); (void)hipDeviceGetAttribute(&cus, hipDeviceAttributeMultiprocessorCount, dev);
        if (hipFuncSetAttribute((const void*)mega, hipFuncAttributeMaxDynamicSharedMemorySize, LDS_BYTES) != hipSuccess) { fprintf(stderr, "kernel_launch: hipFuncSetAttribute failed\n"); grid = -1; return; }
        if (hipOccupancyMaxActiveBlocksPerMultiprocessor(&per_cu, (const void*)mega, NTHR, LDS_BYTES) != hipSuccess || per_cu < 1) { fprintf(stderr, "kernel_launch: occupancy query gave %d\n", per_cu); per_cu = 1; }
        (void)hipGetLastError();
        grid = cus * per_cu;
    }
    if (grid < 0) return;
    Params p{};
    const float** pin = (const float**)&p;
    for (int i = 0; i < 32; ++i) pin[i] = (const float*)d_in[i];
    unsigned char* ws = (unsigned char*)d_ws;
    p.out = (float*)d_out;
    p.WinT = (bf16_t*)(ws + WS_WIN); p.WoutT = (bf16_t*)(ws + WS_WOUT); p.WupT = (bf16_t*)(ws + WS_WUP); p.WdownT = (bf16_t*)(ws + WS_WDOWN); p.WgluT = (bf16_t*)(ws + WS_WGLU);
    p.mod = (float*)(ws + WS_MOD); p.M2T = (bf16_t*)(ws + WS_M2T); p.McatT = (bf16_t*)(ws + WS_MCAT); p.L16 = (float*)(ws + WS_L16); p.hc = (float*)(ws + WS_HC);
    p.A1 = (bf16_t*)(ws + WS_A1); p.big = ws + WS_BIG; p.bar = (unsigned*)(ws + WS_BAR);
    if (hipMemsetAsync(ws + WS_BAR, 0, 16384, stream) != hipSuccess) { fprintf(stderr, "kernel_launch: memset failed\n"); return; }
#if COOP
    p.ph_lo = 0; p.ph_hi = 25;
    void* args[] = {&p};
    hipError_t e = hipLaunchCooperativeKernel((const void*)mega, dim3(grid), dim3(NTHR), args, LDS_BYTES, stream);
    if (e != hipSuccess) fprintf(stderr, "cooperative launch failed: %s (grid %d)\n", hipGetErrorString(e), grid);
#else
    for (int ph = 0; ph < 25; ++ph) {
        if (ph == 13) continue;
        p.ph_lo = ph; p.ph_hi = ph + 1;
        hipLaunchKernelGGL(mega, dim3(grid), dim3(NTHR), LDS_BYTES, stream, p);
    }
#endif
}
```

```cpp
#include <hip/hip_runtime.h>
#include <hip/hip_cooperative_groups.h>
#include <cstdio>
namespace cg = cooperative_groups;

#ifndef COOP
#define COOP 1
#endif

#define LAS __attribute__((address_space(3)))
typedef unsigned short bf16_t;
typedef short bf16x8 __attribute__((ext_vector_type(8)));
typedef float f32x4 __attribute__((ext_vector_type(4)));
typedef float f32x2 __attribute__((ext_vector_type(2)));
typedef unsigned u32x4 __attribute__((ext_vector_type(4)));
typedef unsigned u32x2 __attribute__((ext_vector_type(2)));

constexpr int NTHR = 512;
constexpr int MROWS = 33792, LROWS = 32768, DM = 1024, ZLD = 3072, DFF = 2816, DIN = 2992;
constexpr int LDS_MAIN = 150 * 1024;
constexpr int LDS_BYTES = LDS_MAIN + 16;
constexpr float ALPHA_C = 1.41421356237f;
constexpr int ZC_U5 = 0, ZC_GQ = 256, ZC_GK = 448, ZC_GV = 640, ZC_GR = 1024, ZC_GLR = 1408, ZC_MQ = 1440, ZC_MK = 1824, ZC_MV = 2208, ZC_MO = 2592, ZC_MIG = 2976, ZC_MFG = 2984;

struct Params {
    const float *x, *c, *ctx, *c_ctx, *w_ada, *b_ada, *w_in, *s5_a_re, *s5_a_im, *s5_log_dt, *s5_b_re, *s5_b_im, *s5_c_re, *s5_c_im, *s5_d, *s5_w_glu, *s5_b_glu,
        *gla_w_a2, *gla_b_a, *gla_g, *ml_i_bias, *ml_f_bias, *ml_g, *w_out, *ln1_g, *ln1_b, *w_up, *w_dconv, *b_dconv, *w_down, *ln2_g, *ln2_b;
    float* out;
    bf16_t *WinT, *WoutT, *WupT, *WdownT, *WgluT;
    float* mod;
    bf16_t *M2T, *McatT;
    float* L16;
    float* hc;
    bf16_t* A1;
    unsigned char* big;
    unsigned* bar;
    int ph_lo, ph_hi;
};

#define PRM const __attribute__((address_space(4))) Params&
constexpr size_t WS_WIN = 0;
constexpr size_t WS_WOUT = WS_WIN + 2ull * 3072 * 1024 * 2;
constexpr size_t WS_WUP = WS_WOUT + 2ull * 1024 * 1024 * 2;
constexpr size_t WS_WDOWN = WS_WUP + 2ull * 5632 * 1024 * 2;
constexpr size_t WS_WGLU = WS_WDOWN + 2ull * 1024 * 2816 * 2;
constexpr size_t WS_MOD = WS_WGLU + 2ull * 256 * 256 * 2;
constexpr size_t WS_M2T = WS_MOD + 2ull * 5 * 6144 * 4;
constexpr size_t WS_MCAT = WS_M2T + 2ull * 16 * 256 * 256 * 2;
constexpr size_t WS_L16 = WS_MCAT + 2ull * 16 * 256 * 512 * 2;
constexpr size_t WS_HC = WS_L16 + 2ull * 2 * 16 * 64 * 2 * 4;
constexpr size_t WS_A1 = WS_HC + 1024ull * 1024 * 4;
constexpr size_t WS_BIG = WS_A1 + (size_t)MROWS * 1024 * 2;
constexpr size_t BIG_BYTES = (size_t)MROWS * 5632 * 2;
constexpr size_t WS_BAR = WS_BIG + BIG_BYTES;
constexpr size_t WS_END = WS_BAR + 16384;
constexpr size_t BIG_Z = 0;
constexpr size_t BIG_OBUF = BIG_Z + (size_t)MROWS * ZLD * 2;
constexpr size_t BIG_LOC = BIG_OBUF + 2ull * MROWS * 768 * 2;
constexpr size_t BIG_XE = BIG_LOC + 2ull * 4 * 16 * 528 * 128 * 4;
constexpr size_t BIG_G5 = BIG_XE + 2ull * 4 * 528 * 16 * 128 * 2;
constexpr size_t BIG_Y = 0;
constexpr size_t BIG_A = 0;
constexpr size_t BIG_V = (size_t)MROWS * DFF * 2;
static_assert(BIG_G5 + (size_t)MROWS * 256 * 2 <= BIG_BYTES, "big map");
constexpr size_t A1_QD = 0;
constexpr size_t A1_KD = A1_QD + (size_t)MROWS * 384 * 2;
constexpr size_t A1_BL = A1_KD + (size_t)MROWS * 384 * 2;
constexpr size_t A1_G4 = A1_BL + 528ull * 8 * 48 * 4;
constexpr size_t A1_CH = A1_G4 + (size_t)MROWS * 32 * 4;
constexpr size_t A1_DN = A1_CH + 528ull * 8 * 2 * 4;
constexpr size_t A1_DI = A1_DN + 528ull * 8 * 96 * 4;
constexpr size_t A1_MLS = A1_DI + (size_t)MROWS * 8 * 4;
constexpr size_t A1_MLN = A1_MLS + 96ull * 2 * 256 * 12 * 4;
constexpr size_t A1_GLS = A1_MLN + 96ull * 2 * 128 * 4;
static_assert(A1_GLS + 96ull * 256 * 8 * 4 <= (size_t)MROWS * 1024 * 2, "a1 map");

struct Ctx { int tid, bid, nb; };
__device__ __forceinline__ float bf2f(bf16_t b) { return __uint_as_float(((unsigned)b) << 16); }
typedef __bf16 bf16v2_t __attribute__((ext_vector_type(2)));
__device__ __forceinline__ bf16_t f2bf(float f) { return __builtin_bit_cast(unsigned short, (__bf16)f); }
__device__ __forceinline__ unsigned pk2(float lo, float hi) { bf16v2_t v; v[0] = (__bf16)lo; v[1] = (__bf16)hi; return __builtin_bit_cast(unsigned, v); }
__device__ __forceinline__ float lo2f(unsigned w) { return __uint_as_float(w << 16); }
__device__ __forceinline__ float hi2f(unsigned w) { return __uint_as_float(w & 0xFFFF0000u); }
__device__ __forceinline__ float sigmoidf_(float x) { return 1.0f / (1.0f + __expf(-x)); }
__device__ __forceinline__ float logsigmoidf_(float x) { return fminf(x, 0.f) - log1pf(__expf(-fabsf(x))); }
__device__ __forceinline__ float gelu_tanh(float x) { const float u = 0.7978845608f * (x + 0.044715f * x * x * x); const float t = 1.0f - 2.0f / (__expf(2.0f * u) + 1.0f); return 0.5f * x * (1.0f + t); }
__device__ __forceinline__ float siluf_(float x) { return x / (1.0f + __expf(-x)); }
__device__ __forceinline__ int mod_row(int row) { return row < LROWS ? (row >> 13) : 4; }
__device__ __forceinline__ float wave_sum(float v) {
#pragma unroll
    for (int o = 32; o > 0; o >>= 1) v += __shfl_xor(v, o, 64);
    return v;
}
__device__ __forceinline__ float wave_max(float v) {
#pragma unroll
    for (int o = 32; o > 0; o >>= 1) v = fmaxf(v, __shfl_xor(v, o, 64));
    return v;
}
__device__ __forceinline__ f32x4 mfma16(bf16x8 a, bf16x8 b, f32x4 c) { return __builtin_amdgcn_mfma_f32_16x16x32_bf16(a, b, c, 0, 0, 0); }

namespace pg8 {
constexpr int BM = 256, BK = 64, HALF = 128, HTB = HALF * BK * 2, STAGE_BYTES = 8 * HTB, NXCD = 8, WGM = 8;
__device__ __forceinline__ int lds_byte(int r, int c) { const int st = (r >> 4) * 2 + (c >> 5), rr = r & 15, cc = c & 31, ob = rr * 64 + cc * 2; return st * 1024 + (ob ^ (((ob >> 9) & 1) << 5)); }
__device__ __forceinline__ void stage_rc(int b, int& R, int& C) { const int st = b / 1024, sb = b % 1024, swz = sb ^ (((sb >> 9) & 1) << 5); R = (st >> 1) * 16 + swz / 64; C = (st & 1) * 32 + (swz % 64) / 2; }
__device__ __forceinline__ int perm32(int rho) { const int n = rho >> 4, i = rho & 15; return 8 * (i >> 2) + 4 * n + (i & 3); }
struct Unit { int pm, pn; };
struct Gemm { const bf16_t* A; const bf16_t* Bt; int M, N, K; };
struct StaticOrder {
    int nM, nN, nwg, G, c;
    __device__ void init(int M, int N, int G_, int c_) { nM = M / BM; nN = N / BM; nwg = nM * nN; G = G_; c = c_; }
    __device__ bool next(int i, Unit& u) const {
        const long L = (long)i * G + c; if (L >= nwg) return false;
        int wgid = (int)L; { const int q = nwg / NXCD, r = nwg % NXCD, xcd = wgid % NXCD, off = wgid / NXCD; wgid = (xcd < r ? xcd * (q + 1) : r * (q + 1) + (xcd - r) * q) + off; }
        const int nig = WGM * nN, gid = wgid / nig, fm = gid * WGM, gsz = (nM - fm) < WGM ? (nM - fm) : WGM;
        u.pm = fm + ((wgid % nig) % gsz); u.pn = (wgid % nig) / gsz; return true;
    }
    __device__ __forceinline__ void a_ready(const Unit&) const {}
    __device__ __forceinline__ void done(const Unit&) const {}
};
__device__ __forceinline__ unsigned cvt_pk_bf16(float lo, float hi) { return pk2(lo, hi); }

struct EpiF32 {
    static constexpr bool PERM = false;
    float* C; int ldc;
    __device__ __forceinline__ void operator()(const f32x4 (&acc)[2][2][4][2], const Unit& u, int wr, int wc, int fr, int fq) const {
        const int row0 = u.pm * BM + wr * 64 + fr, col0 = u.pn * BM + wc * 32 + 4 * fq;
#pragma unroll
        for (int ai = 0; ai < 2; ++ai)
#pragma unroll
            for (int m = 0; m < 4; ++m) { float* rowp = C + (size_t)(row0 + ai * HALF + m * 16) * ldc + col0;
#pragma unroll
                for (int bj = 0; bj < 2; ++bj)
#pragma unroll
                    for (int n = 0; n < 2; ++n) *(f32x4*)(rowp + bj * HALF + n * 16) = acc[ai][bj][m][n]; }
    }
};
struct EpiBf16 {
    static constexpr bool PERM = true;
    bf16_t* O; int ldc; int split_cols; size_t split_stride;
    __device__ __forceinline__ void operator()(const f32x4 (&acc)[2][2][4][2], const Unit& u, int wr, int wc, int fr, int fq) const {
        const int row0 = u.pm * BM + wr * 64 + fr; int colt = u.pn * BM; bf16_t* base = O;
        if (split_cols) { const int t = colt / split_cols; base += (size_t)t * split_stride; colt -= t * split_cols; }
        const int col0 = colt + wc * 32 + 8 * fq;
#pragma unroll
        for (int ai = 0; ai < 2; ++ai)
#pragma unroll
            for (int m = 0; m < 4; ++m) { bf16_t* rowp = base + (size_t)(row0 + ai * HALF + m * 16) * ldc + col0;
#pragma unroll
                for (int bj = 0; bj < 2; ++bj) { const f32x4 v0 = acc[ai][bj][m][0], v1 = acc[ai][bj][m][1];
                    u32x4 w; w.x = cvt_pk_bf16(v0[0], v0[1]); w.y = cvt_pk_bf16(v0[2], v0[3]); w.z = cvt_pk_bf16(v1[0], v1[1]); w.w = cvt_pk_bf16(v1[2], v1[3]);
                    *(u32x4*)(rowp + bj * HALF) = w; } }
    }
};
template <class Epi, class Sched>
__device__ __forceinline__ void gemm_phase(const Ctx& cx, LAS unsigned char* lds, const Gemm g, const Sched& S, const Epi& E) {
    const int tid = cx.tid, wid = __builtin_amdgcn_readfirstlane(tid >> 6), lane = tid & 63, wr = wid >> 2, wc = wid & 3, fr = lane & 15, fq = lane >> 4;
    const int K = g.K, nt = K / BK;
    unsigned voffA[2], voffB[2];
#pragma unroll
    for (int i = 0; i < 2; ++i) { int R, C; stage_rc(tid * 16 + i * 8192, R, C); const int Rb = Epi::PERM ? ((R & ~31) + perm32(R & 31)) : R;
        voffA[i] = (unsigned)(R * K + C) * 2u; voffB[i] = (unsigned)(Rb * K + C) * 2u; }
    const size_t kstep = (size_t)(BK * 2);
    const size_t hstep = (size_t)HALF * K * 2;
    const size_t tstep = 2 * hstep;
    const unsigned ldsw = (unsigned)wid * 1024u;
    const int aoff = lds_byte(wr * 64 + fr, fq * 8), boff = lds_byte(wc * 32 + fr, fq * 8);
#define PG8_SA(b, h) (((b) * 2 + (h)) * HTB)
#define PG8_SB(b, h) ((4 + (b) * 2 + (h)) * HTB)
#define PG8_STAGE(bufoff, gbase, voff) do { _Pragma("unroll") for (int _i = 0; _i < 2; ++_i) \
        __builtin_amdgcn_global_load_lds((const unsigned*)((const char*)(gbase) + (voff)[_i]), (LAS unsigned*)(lds + (bufoff) + ldsw + _i * 8192), 16, 0, 0); } while (0)
#define PG8_LDA(dst, b, h) do { _Pragma("unroll") for (int m = 0; m < 4; ++m) _Pragma("unroll") for (int k = 0; k < 2; ++k) dst[m][k] = *(const LAS bf16x8*)(lds + PG8_SA(b, h) + aoff + m * 2048 + k * 1024); } while (0)
#define PG8_LDB(dst, b, h) do { _Pragma("unroll") for (int n = 0; n < 2; ++n) _Pragma("unroll") for (int k = 0; k < 2; ++k) dst[n][k] = *(const LAS bf16x8*)(lds + PG8_SB(b, h) + boff + n * 2048 + k * 1024); } while (0)
#define PG8_MMA(ai, bj, At, Bt) do { __builtin_amdgcn_s_setprio(1); _Pragma("unroll") for (int m = 0; m < 4; ++m) _Pragma("unroll") for (int n = 0; n < 2; ++n) _Pragma("unroll") for (int k = 0; k < 2; ++k) \
        acc[ai][bj][m][n] = __builtin_amdgcn_mfma_f32_16x16x32_bf16(Bt[n][k], At[m][k], acc[ai][bj][m][n], 0, 0, 0); __builtin_amdgcn_s_setprio(0); } while (0)
#define PG8_WAIT_V(n) asm volatile("s_waitcnt vmcnt(" #n ")" ::: "memory")
#define PG8_WAIT_L(n) asm volatile("s_waitcnt lgkmcnt(" #n ")" ::: "memory")
#define PG8_BAR __builtin_amdgcn_s_barrier()
#define PG8_SCHED __builtin_amdgcn_sched_barrier(0)
    Unit cur, nxt; int ui = 0;
    if (!S.next(0, cur)) return;
    f32x4 acc[2][2][4][2];
#pragma unroll
    for (int a = 0; a < 2; ++a)
#pragma unroll
        for (int b = 0; b < 2; ++b)
#pragma unroll
            for (int m = 0; m < 4; ++m)
#pragma unroll
                for (int n = 0; n < 2; ++n) acc[a][b][m][n] = (f32x4){0.f, 0.f, 0.f, 0.f};
    bf16x8 At[4][2], B0[2][2], B1[2][2];
    const char* cA = (const char*)g.A + (size_t)cur.pm * tstep; const char* cB = (const char*)g.Bt + (size_t)cur.pn * tstep;
    S.a_ready(cur);
    PG8_STAGE(PG8_SB(0, 0), cB, voffB); PG8_STAGE(PG8_SA(0, 0), cA, voffA); PG8_STAGE(PG8_SB(0, 1), cB + hstep, voffB); PG8_STAGE(PG8_SA(0, 1), cA + hstep, voffA);
    if (wr == 1) PG8_BAR;
    PG8_WAIT_V(4); PG8_BAR;
    PG8_STAGE(PG8_SB(1, 0), cB + kstep, voffB); PG8_STAGE(PG8_SA(1, 0), cA + kstep, voffA); PG8_STAGE(PG8_SB(1, 1), cB + hstep + kstep, voffB);
    PG8_WAIT_V(6); PG8_BAR;
    for (;;) {
        const bool has_next = S.next(ui + 1, nxt);
        const char* nA = has_next ? (const char*)g.A + (size_t)nxt.pm * tstep : cA; const char* nB = has_next ? (const char*)g.Bt + (size_t)nxt.pn * tstep : cB;
        for (int t = 0; t < nt; t += 2) {
            const bool last = (t == nt - 2);
            const char* a1 = cA + (size_t)(t + 1) * kstep;
            const char* a2 = last ? nA : cA + (size_t)(t + 2) * kstep; const char* b2 = last ? nB : cB + (size_t)(t + 2) * kstep;
            const char* a3 = a2 + kstep; const char* b3 = b2 + kstep;
            if (last && has_next) S.a_ready(nxt);
            PG8_LDB(B0, 0, 0); PG8_SCHED; PG8_LDA(At, 0, 0); PG8_STAGE(PG8_SA(1, 1), a1 + hstep, voffA);
            PG8_WAIT_L(8); PG8_BAR; PG8_WAIT_L(0); PG8_MMA(0, 0, At, B0); PG8_BAR; PG8_SCHED;
            PG8_LDB(B1, 0, 1); PG8_STAGE(PG8_SB(0, 0), b2, voffB);
            PG8_BAR; PG8_WAIT_L(0); PG8_MMA(0, 1, At, B1); PG8_BAR;
            PG8_LDA(At, 0, 1); PG8_STAGE(PG8_SA(0, 0), a2, voffA);
            PG8_BAR; PG8_WAIT_L(0); PG8_MMA(1, 0, At, B0); PG8_BAR; PG8_SCHED;
            PG8_STAGE(PG8_SB(0, 1), b2 + hstep, voffB);
            PG8_WAIT_V(6); PG8_BAR; PG8_MMA(1, 1, At, B1); PG8_BAR;
            PG8_LDB(B0, 1, 0); PG8_SCHED; PG8_LDA(At, 1, 0); PG8_STAGE(PG8_SA(0, 1), a2 + hstep, voffA);
            PG8_WAIT_L(8); PG8_BAR; PG8_WAIT_L(0); PG8_MMA(0, 0, At, B0); PG8_BAR; PG8_SCHED;
            PG8_LDB(B1, 1, 1); PG8_STAGE(PG8_SB(1, 0), b3, voffB);
            PG8_BAR; PG8_WAIT_L(0); PG8_MMA(0, 1, At, B1); PG8_BAR;
            PG8_LDA(At, 1, 1); PG8_STAGE(PG8_SA(1, 0), a3, voffA);
            PG8_BAR; PG8_WAIT_L(0); PG8_MMA(1, 0, At, B0); PG8_BAR; PG8_SCHED;
            PG8_STAGE(PG8_SB(1, 1), b3 + hstep, voffB);
            PG8_WAIT_V(6); PG8_BAR; PG8_MMA(1, 1, At, B1); PG8_BAR;
        }
        E(acc, cur, wr, wc, fr, fq); S.done(cur);
        if (!has_next) break;
#pragma unroll
        for (int a = 0; a < 2; ++a)
#pragma unroll
            for (int b = 0; b < 2; ++b)
#pragma unroll
                for (int m = 0; m < 4; ++m)
#pragma unroll
                    for (int n = 0; n < 2; ++n) acc[a][b][m][n] = (f32x4){0.f, 0.f, 0.f, 0.f};
        cur = nxt; cA = nA; cB = nB; ++ui;
    }
    PG8_WAIT_V(0);
    if (wr == 0) PG8_BAR;
    PG8_BAR;
#undef PG8_SA
#undef PG8_SB
#undef PG8_STAGE
#undef PG8_LDA
#undef PG8_LDB
#undef PG8_MMA
#undef PG8_WAIT_V
#undef PG8_WAIT_L
#undef PG8_BAR
#undef PG8_SCHED
}
}

template <class Epi>
__device__ __forceinline__ void run_gemm(const Ctx& cx, unsigned char* smem, const bf16_t* A, const bf16_t* Bt, int M, int N, int K, const Epi& E) {
    pg8::Gemm g; g.A = A; g.Bt = Bt; g.M = M; g.N = N; g.K = K;
    pg8::StaticOrder S; S.init(M, N, (int)cx.nb, (int)cx.bid);
    pg8::gemm_phase<Epi, pg8::StaticOrder>(cx, (LAS unsigned char*)smem, g, S, E);
}

__device__ void p0_s5_setup(const Ctx& cx, PRM p, int u, unsigned char* smem) {
    const int l = u >> 5, g = (u >> 1) & 15, th = u & 1, tid = cx.tid;
    float* LP = (float*)smem;
    float* BB = LP + 2 * 17 * 64 * 2;
    float* CC = BB + 2 * 64 * 16 * 2;
    __syncthreads();
    for (int i = tid; i < 2 * 17 * 64; i += NTHR) {
        const int d = i / (17 * 64), n = (i / 64) % 17, pp = i & 63;
        const int gi = ((l * 2 + d) * 16 + g);
        const float dt = expf(p.s5_log_dt[gi]); const float ar = p.s5_a_re[gi * 64 + pp], ai = p.s5_a_im[gi * 64 + pp];
        const float mag = expf(ar * dt * (float)n); float sn, cs; sincosf(ai * dt * (float)n, &sn, &cs);
        LP[i * 2] = mag * cs; LP[i * 2 + 1] = mag * sn;
    }
    for (int i = tid; i < 2 * 16 * 64; i += NTHR) {
        const int d = i / 1024, hh = (i / 64) & 15, pp = i & 63;
        const size_t gi = ((size_t)(l * 2 + d) * 16 + g);
        CC[i * 2] = p.s5_c_re[(gi * 16 + hh) * 64 + pp]; CC[i * 2 + 1] = p.s5_c_im[(gi * 16 + hh) * 64 + pp];
    }
    __syncthreads();
    for (int i = tid; i < 2 * 64 * 16; i += NTHR) {
        const int d = i / 1024, pp = (i / 16) & 63, hh = i & 15;
        const int gi = ((l * 2 + d) * 16 + g);
        const float ar = p.s5_a_re[gi * 64 + pp], ai = p.s5_a_im[gi * 64 + pp];
        const float lr = LP[((d * 17 + 1) * 64 + pp) * 2], li = LP[((d * 17 + 1) * 64 + pp) * 2 + 1];
        const float den = ar * ar + ai * ai;
        const float zr = ((lr - 1.0f) * ar + li * ai) / den, zi = (li * ar - (lr - 1.0f) * ai) / den;
        const float br = p.s5_b_re[((size_t)gi * 64 + pp) * 16 + hh], bi = p.s5_b_im[((size_t)gi * 64 + pp) * 16 + hh];
        BB[i * 2] = zr * br - zi * bi; BB[i * 2 + 1] = zr * bi + zi * br;
    }
    __syncthreads();
    float* KT = CC + 2 * 16 * 64 * 2;
    for (int e0 = tid; e0 < 6144; e0 += NTHR) {
        const int sh = th == 0 ? 2048 : 4096;
        const int d = e0 < sh ? 0 : 1, e = d == 0 ? e0 : 4096 + (e0 - sh);
        const int tau = (e >> 8) & 15, hh = (e >> 4) & 15, h2 = e & 15; float acc = 0.f;
        for (int pp = 0; pp < 64; ++pp) {
            const float Lr = LP[((d * 17 + tau) * 64 + pp) * 2], Li = LP[((d * 17 + tau) * 64 + pp) * 2 + 1];
            const float br = BB[((d * 64 + pp) * 16 + h2) * 2], bi = BB[((d * 64 + pp) * 16 + h2) * 2 + 1];
            const float cr = CC[((d * 16 + hh) * 64 + pp) * 2], ci = CC[((d * 16 + hh) * 64 + pp) * 2 + 1];
            const float wr = Lr * br - Li * bi, wi = Lr * bi + Li * br;
            acc += cr * wr - ci * wi; }
        KT[e] = acc;
    }
    __syncthreads();
    bf16_t* mc = p.McatT + (size_t)(l * 16 + g) * 256 * 512 + (size_t)th * 128 * 512;
    for (int e = tid; e < 128 * 512; e += NTHR) {
        const int n = th * 128 + (e >> 9), k = e & 511, t = n >> 4, hh = n & 15; float val = 0.f;
        if (k < 256) {
            const int s = k >> 4, h2 = k & 15;
            if (t >= s) val += KT[((0 * 16 + (t - s)) * 16 + hh) * 16 + h2];
            if (s >= t) val += KT[((1 * 16 + (s - t)) * 16 + hh) * 16 + h2];
            if (s == t && h2 == hh) val += p.s5_d[l * 256 + g * 16 + hh];
        } else {
            const int kk = k - 256, d = kk >> 7, part = (kk >> 6) & 1, pp = kk & 63, npow = d == 0 ? t + 1 : 16 - t;
            const float Lr = LP[((d * 17 + npow) * 64 + pp) * 2], Li = LP[((d * 17 + npow) * 64 + pp) * 2 + 1];
            const float cr = CC[((d * 16 + hh) * 64 + pp) * 2], ci = CC[((d * 16 + hh) * 64 + pp) * 2 + 1];
            val = part == 0 ? (cr * Lr - ci * Li) : -(cr * Li + ci * Lr);
        }
        mc[e] = f2bf(val);
    }
    bf16_t* m2 = p.M2T + (size_t)(l * 16 + g) * 256 * 256 + (size_t)th * 128 * 256;
    for (int e = tid; e < 128 * 256; e += NTHR) {
        const int n2 = th * 128 + (e >> 8), k = e & 255, d = n2 >> 7, part = (n2 >> 6) & 1, pp = n2 & 63, s = k >> 4, h2 = k & 15;
        const int ex = d == 0 ? 15 - s : s;
        const float Lr = LP[((d * 17 + ex) * 64 + pp) * 2], Li = LP[((d * 17 + ex) * 64 + pp) * 2 + 1];
        const float br = BB[((d * 64 + pp) * 16 + h2) * 2], bi = BB[((d * 64 + pp) * 16 + h2) * 2 + 1];
        m2[e] = f2bf(part == 0 ? (Lr * br - Li * bi) : (Lr * bi + Li * br));
    }
    if (th == 0 && tid < 128) { const int d = tid >> 6, pp = tid & 63;
        float* o = p.L16 + ((size_t)((l * 2 + d) * 16 + g) * 64 + pp) * 2;
        o[0] = LP[((d * 17 + 16) * 64 + pp) * 2]; o[1] = LP[((d * 17 + 16) * 64 + pp) * 2 + 1]; }
}

__device__ void p0_mod(const Ctx& cx, PRM p, int u, unsigned char* smem) {
    const int l = u / 48, cb = u % 48, tid = cx.tid;
    float* sc = (float*)smem;
    float* red = sc + 5 * 1024;
    __syncthreads();
    for (int i = tid; i < 5 * 1024; i += NTHR) { const int r = i >> 10, k = i & 1023; const float v = r < 4 ? p.c[r * 1024 + k] : p.c_ctx[k]; sc[i] = siluf_(v); }
    __syncthreads();
    const int col = tid & 127, part = tid >> 7, j = cb * 128 + col;
    float a0 = 0.f, a1 = 0.f, a2 = 0.f, a3 = 0.f, a4 = 0.f;
    const float* w = p.w_ada + (size_t)l * 1024 * 6144 + j;
    for (int i = part * 256; i < part * 256 + 256; ++i) { const float wv = w[(size_t)i * 6144];
        a0 += sc[i] * wv; a1 += sc[1024 + i] * wv; a2 += sc[2048 + i] * wv; a3 += sc[3072 + i] * wv; a4 += sc[4096 + i] * wv; }
    red[(part * 5 + 0) * 128 + col] = a0; red[(part * 5 + 1) * 128 + col] = a1; red[(part * 5 + 2) * 128 + col] = a2; red[(part * 5 + 3) * 128 + col] = a3; red[(part * 5 + 4) * 128 + col] = a4;
    __syncthreads();
    for (int o = tid; o < 640; o += NTHR) { const int r = o >> 7, cc = o & 127, jj = cb * 128 + cc;
        const float s = red[(0 * 5 + r) * 128 + cc] + red[(1 * 5 + r) * 128 + cc] + red[(2 * 5 + r) * 128 + cc] + red[(3 * 5 + r) * 128 + cc];
        p.mod[((size_t)l * 5 + r) * 6144 + jj] = s + p.b_ada[l * 6144 + jj]; }
}

__device__ void p0_transpose(const Ctx& cx, const float* __restrict__ src, bf16_t* __restrict__ dst, int K, int N, int u, int nkt, unsigned char* smem, bool win = false) {
    const int nt_ = u / nkt, kt = u % nkt, tid = cx.tid;
    float* tile = (float*)smem;
    __syncthreads();
    {
        const int cc = tid & 255, n = nt_ * 256 + cc, r0 = tid >> 8;
        float sc_ = 1.0f; if (win) { if (n >= ZC_GQ && n < ZC_GK) sc_ = 0.14433756729f; else if (n >= ZC_MK && n < ZC_MV) sc_ = 0.10206207261f; }
        const float* sp = src + (size_t)(kt * 64 + r0) * N + n;
        float v[32];
#pragma unroll
        for (int i = 0; i < 32; ++i) v[i] = n < N ? sp[(size_t)(2 * i) * N] : 0.f;
#pragma unroll
        for (int i = 0; i < 32; ++i) tile[(r0 + 2 * i) * 257 + cc] = v[i] * sc_;
    }
    __syncthreads();
#pragma unroll
    for (int j = 0; j < 4; ++j) {
        const int cc = (tid >> 3) + 64 * j, r0 = (tid & 7) * 8;
        u32x4 w;
        w.x = pk2(tile[(r0 + 0) * 257 + cc], tile[(r0 + 1) * 257 + cc]); w.y = pk2(tile[(r0 + 2) * 257 + cc], tile[(r0 + 3) * 257 + cc]);
        w.z = pk2(tile[(r0 + 4) * 257 + cc], tile[(r0 + 5) * 257 + cc]); w.w = pk2(tile[(r0 + 6) * 257 + cc], tile[(r0 + 7) * 257 + cc]);
        *(u32x4*)(dst + (size_t)(nt_ * 256 + cc) * K + kt * 64 + r0) = w;
    }
}

__device__ void phase0(const Ctx& cx, PRM p, unsigned char* smem) {
    constexpr int U_S5 = 64, U_MOD = 96, U_L = 788, U_TOT = U_MOD + 2 * U_L;
    if (cx.bid < U_S5) { p0_s5_setup(cx, p, cx.bid, smem); return; }
    for (int u = cx.bid - U_S5; u < U_TOT; u += cx.nb - U_S5) {
        if (u < U_MOD) p0_mod(cx, p, u, smem);
        else {
            int v = u - U_MOD; const int l = v / U_L; v -= l * U_L;
            const float* src; bf16_t* dst; int K_, N_, nkt_; bool win_ = false;
            if (v < 192) { src = p.w_in + (size_t)l * 1024 * DIN; dst = p.WinT + (size_t)l * 3072 * 1024; K_ = 1024; N_ = DIN; nkt_ = 16; win_ = true; }
            else if (v < 256) { v -= 192; src = p.w_out + (size_t)l * 1024 * 1024; dst = p.WoutT + (size_t)l * 1024 * 1024; K_ = 1024; N_ = 1024; nkt_ = 16; }
            else if (v < 608) { v -= 256; src = p.w_up + (size_t)l * 1024 * 5632; dst = p.WupT + (size_t)l * 5632 * 1024; K_ = 1024; N_ = 5632; nkt_ = 16; }
            else if (v < 784) { v -= 608; src = p.w_down + (size_t)l * DFF * 1024; dst = p.WdownT + (size_t)l * 1024 * DFF; K_ = DFF; N_ = 1024; nkt_ = 44; }
            else { v -= 784; src = p.s5_w_glu + (size_t)l * 256 * 256; dst = p.WgluT + (size_t)l * 256 * 256; K_ = 256; N_ = 256; nkt_ = 4; }
            p0_transpose(cx, src, dst, K_, N_, v, nkt_, smem, win_);
        }
    }
}

__device__ __forceinline__ void ln_stats16(const float (&v)[16], float& mu, float& rstd) {
    float s = 0.f;
#pragma unroll
    for (int i = 0; i < 16; ++i) s += v[i];
    mu = wave_sum(s) * (1.0f / 1024.0f);
    float q = 0.f;
#pragma unroll
    for (int i = 0; i < 16; ++i) { const float d = v[i] - mu; q += d * d; }
    rstd = rsqrtf(wave_sum(q) * (1.0f / 1024.0f) + 1e-5f);
}
__device__ __forceinline__ void store_mod_bf16(bf16_t* dst, const float (&v)[16], const float* sh, const float* sc, int lane) {
    float mu, rstd; ln_stats16(v, mu, rstd);
#pragma unroll
    for (int i = 0; i < 4; ++i) { const int c0 = lane * 4 + 256 * i;
        const f32x4 s4 = *(const f32x4*)(sh + c0), c4 = *(const f32x4*)(sc + c0);
        float o[4];
#pragma unroll
        for (int j = 0; j < 4; ++j) o[j] = (v[i * 4 + j] - mu) * rstd * (1.0f + c4[j]) + s4[j];
        u32x2 w; w.x = pk2(o[0], o[1]); w.y = pk2(o[2], o[3]);
        *(u32x2*)(dst + c0) = w; }
}
__device__ void phase_ln_first(const Ctx& cx, PRM p) {
    const int wid = cx.tid >> 6, lane = cx.tid & 63;
    for (int row = cx.bid * 8 + wid; row < MROWS; row += cx.nb * 8) {
        const float* src = row < LROWS ? p.x + (size_t)row * 1024 : p.ctx + (size_t)(row - LROWS) * 1024;
        float v[16];
#pragma unroll
        for (int i = 0; i < 4; ++i) { const f32x4 t = *(const f32x4*)(src + lane * 4 + 256 * i); v[i * 4] = t[0]; v[i * 4 + 1] = t[1]; v[i * 4 + 2] = t[2]; v[i * 4 + 3] = t[3]; }
        const float* md = p.mod + (size_t)(0 * 5 + mod_row(row)) * 6144;
        store_mod_bf16(p.A1 + (size_t)row * 1024, v, md + 0 * 1024, md + 1 * 1024, lane);
    }
}
__device__ __forceinline__ void sub_barrier(const Ctx& cx, unsigned* ctr, unsigned nblk) {
    asm volatile("s_waitcnt vmcnt(0)" ::: "memory");
    __syncthreads();
    if (cx.tid == 0) {
        __builtin_amdgcn_fence(__ATOMIC_RELEASE, "agent");
        asm volatile("s_waitcnt vmcnt(0)" ::: "memory");
        __hip_atomic_fetch_add(ctr, 1u, __ATOMIC_RELAXED, __HIP_MEMORY_SCOPE_AGENT);
        unsigned sp = 0;
        while (__hip_atomic_load(ctr, __ATOMIC_RELAXED, __HIP_MEMORY_SCOPE_AGENT) < nblk) { __builtin_amdgcn_s_sleep(1); if (++sp > (1u << 24)) break; }
        __builtin_amdgcn_fence(__ATOMIC_ACQUIRE, "agent");
        asm volatile("s_waitcnt vmcnt(0)" ::: "memory");
    }
    __syncthreads();
}
__device__ void phase_ln_res(const Ctx& cx, PRM p, int l, int which, unsigned char* smem) {
    const int wid = cx.tid >> 6, lane = cx.tid & 63;
    const bf16_t* y = (const bf16_t*)(p.big + BIG_Y);
    const float* lg = (which == 0 ? p.ln1_g : p.ln2_g) + l * 1024; const float* lb = (which == 0 ? p.ln1_b : p.ln2_b) + l * 1024;
    const bool first_src = (l == 0 && which == 0);
    const bool want_a1 = !(l == 1 && which == 1);
    int row0 = cx.bid * 8 + wid, row1 = LROWS, rstep = cx.nb * 8;
    if (l == 0) {
        if (which == 1) { row1 = MROWS; }
        else if (cx.bid < 16) {
            pg8::EpiBf16 E; E.O = (bf16_t*)(p.big + BIG_Y) + (size_t)LROWS * 1024; E.ldc = 1024; E.split_cols = 0; E.split_stride = 0;
            pg8::Gemm g; g.A = p.A1 + (size_t)LROWS * 1024; g.Bt = p.WoutT; g.M = 1024; g.N = 1024; g.K = 1024;
            pg8::StaticOrder S; S.init(1024, 1024, 16, (int)cx.bid);
            pg8::gemm_phase<pg8::EpiBf16, pg8::StaticOrder>(cx, (LAS unsigned char*)smem, g, S, E);
            sub_barrier(cx, p.bar + 3520, 16u);
            row0 = LROWS + cx.bid * 8 + wid; row1 = MROWS; rstep = 16 * 8;
        } else { row0 = (cx.bid - 16) * 8 + wid; rstep = (cx.nb - 16) * 8; }
    }
    for (int row = row0; row < row1; row += rstep) {
        const float* hs; float* hd;
        if (row < LROWS) { hs = (first_src ? p.x : p.out) + (size_t)row * 1024; hd = p.out + (size_t)row * 1024; }
        else { hs = (first_src ? p.ctx : p.hc) + (size_t)(row - LROWS) * 1024; hd = p.hc + (size_t)(row - LROWS) * 1024; }
        const float* md = p.mod + (size_t)(l * 5 + mod_row(row)) * 6144;
        const float* gate = md + (which == 0 ? 2 : 5) * 1024;
        float v[16];
#pragma unroll
        for (int i = 0; i < 4; ++i) { const int c0 = lane * 4 + 256 * i;
            const f32x4 h4 = *(const f32x4*)(hs + c0), g4 = *(const f32x4*)(gate + c0); const u32x2 yb = *(const u32x2*)((l == 0 && which == 1 && row >= LROWS ? (const bf16_t*)p.A1 : y) + (size_t)row * 1024 + c0); const f32x4 y4 = {lo2f(yb.x), hi2f(yb.x), lo2f(yb.y), hi2f(yb.y)};
#pragma unroll
            for (int j = 0; j < 4; ++j) v[i * 4 + j] = ALPHA_C * h4[j] + g4[j] * y4[j]; }
        float mu, rstd; ln_stats16(v, mu, rstd);
#pragma unroll
        for (int i = 0; i < 4; ++i) { const int c0 = lane * 4 + 256 * i;
            const f32x4 g4 = *(const f32x4*)(lg + c0), b4 = *(const f32x4*)(lb + c0); f32x4 o;
#pragma unroll
            for (int j = 0; j < 4; ++j) { o[j] = (v[i * 4 + j] - mu) * rstd * g4[j] + b4[j]; v[i * 4 + j] = o[j]; }
            *(f32x4*)(hd + c0) = o; }
        if (want_a1) {
            const float* md2 = which == 0 ? md : p.mod + (size_t)((l + 1) * 5 + mod_row(row)) * 6144;
            const int si = which == 0 ? 3 : 0;
            store_mod_bf16(p.A1 + (size_t)row * 1024, v, md2 + si * 1024, md2 + (si + 1) * 1024, lane);
        }
    }
}

__device__ __forceinline__ int s5_rowbase(int q) { const int b = q / 528, j = q % 528; return j < 16 ? LROWS + b * 256 + j * 16 : b * 8192 + (j - 16) * 16; }

__device__ void phase_s5a(const Ctx& cx, PRM p, int l, unsigned char* smem, const int b0) {
    const int tid = cx.tid, wid = tid >> 6, lane = tid & 63, fr = lane & 15, fq = lane >> 4;
    const bf16_t* __restrict__ z = (const bf16_t*)(p.big + BIG_Z);
    float* __restrict__ loc = (float*)(p.big + BIG_LOC);
    constexpr int RS = 528;
    for (int bj = cx.bid - b0; bj < 144; bj += cx.nb - b0) {
        const int g = 2 * (bj & 7) + (bj >> 3) / 9, cb = (bj >> 3) % 9;
        const unsigned char* __restrict__ m2 = (const unsigned char*)(p.M2T + (size_t)(l * 16 + g) * 256 * 256);
        __syncthreads();
        { u32x4 st_[16];
#pragma unroll
            for (int k = 0; k < 16; ++k) { const int i = tid + k * NTHR, r = i >> 5, c = i & 31; st_[k] = *(const u32x4*)(m2 + (size_t)r * 512 + c * 16); }
#pragma unroll
            for (int k = 0; k < 16; ++k) { const int i = tid + k * NTHR, r = i >> 5, c = i & 31; *(u32x4*)(smem + r * RS + c * 16) = st_[k]; } }
        __syncthreads();
#pragma unroll 1
        for (int jb = 0; jb < 2; ++jb) {
            const int cgp = cb * 16 + jb * 8 + wid;
            if (cgp < 132) {
                const int rb = s5_rowbase(cgp * 16 + fr);
                bf16x8 a[8];
#pragma unroll
                for (int kk = 0; kk < 8; ++kk) a[kk] = *(const bf16x8*)(z + (size_t)(rb + kk * 2 + (fq >> 1)) * ZLD + ZC_U5 + g * 16 + (fq & 1) * 8);
#pragma unroll 2
                for (int ntl = 0; ntl < 16; ++ntl) {
                    f32x4 acc = {0.f, 0.f, 0.f, 0.f};
#pragma unroll
                    for (int kk = 0; kk < 8; ++kk) { const bf16x8 bb = *(const bf16x8*)(smem + (ntl * 16 + fr) * RS + kk * 64 + fq * 16); acc = mfma16(a[kk], bb, acc); }
                    const int n2 = ntl * 16 + fr, d = n2 >> 7, n = n2 & 127;
#pragma unroll
                    for (int jj = 0; jj < 4; ++jj) { const int q = cgp * 16 + fq * 4 + jj, b = q / 528, j = q % 528;
                        loc[((size_t)((d * 4 + b) * 16 + g) * 528 + j) * 128 + n] = acc[jj]; }
                }
            }
        }
    }
    __syncthreads();
}
__device__ void s5_carry(PRM p, int l, int chain, int lane) {
    const int d = chain >> 6, b = (chain >> 4) & 3, g = chain & 15;
    const float* loc = (const float*)(p.big + BIG_LOC) + (size_t)((d * 4 + b) * 16 + g) * 528 * 128;
    bf16_t* xe = (bf16_t*)(p.big + BIG_XE) + (size_t)(d * 4 + b) * 528 * 16 * 128 + (size_t)g * 128;
    const float* L = p.L16 + ((size_t)((l * 2 + d) * 16 + g) * 64 + lane) * 2;
    const float Lr = L[0], Li = L[1];
    float sr = 0.f, si = 0.f;
    for (int s0 = 0; s0 < 528; s0 += 24) {
        float vr[24], vi[24];
#pragma unroll
        for (int i = 0; i < 24; ++i) { const int s = s0 + i; const int j = d == 0 ? s : (s < 16 ? 15 - s : 543 - s); vr[i] = loc[(size_t)j * 128 + lane]; vi[i] = loc[(size_t)j * 128 + 64 + lane]; }
#pragma unroll
        for (int i = 0; i < 24; ++i) { const int s = s0 + i; const int j = d == 0 ? s : (s < 16 ? 15 - s : 543 - s);
            xe[(size_t)j * 2048 + lane] = f2bf(sr); xe[(size_t)j * 2048 + 64 + lane] = f2bf(si);
            const float nr = Lr * sr - Li * si + vr[i], ni = Lr * si + Li * sr + vi[i]; sr = nr; si = ni; }
    }
}
__device__ void phase_s5c(const Ctx& cx, PRM p, int l, unsigned char* smem) {
    const int tid = cx.tid, wid = tid >> 6, lane = tid & 63, fr = lane & 15, fq = lane >> 4;
    const bf16_t* __restrict__ z = (const bf16_t*)(p.big + BIG_Z);
    const bf16_t* __restrict__ xe = (const bf16_t*)(p.big + BIG_XE);
    bf16_t* __restrict__ g5 = (bf16_t*)(p.big + BIG_G5);
    constexpr int RS = 1040;
    for (int bj = cx.bid; bj < 144; bj += cx.nb) {
        const int g = 2 * (bj & 7) + (bj >> 3) / 9, cb = (bj >> 3) % 9;
        const unsigned char* __restrict__ mc = (const unsigned char*)(p.McatT + (size_t)(l * 16 + g) * 256 * 512);
        const int cg0 = cb * 16 + wid, cg1 = cg0 + 8;
        const bool on0 = cg0 < 132, on1 = cg1 < 132;
        const int qa0 = (on0 ? cg0 : 0) * 16 + fr, qa1 = (on1 ? cg1 : 0) * 16 + fr;
        const int rb0 = s5_rowbase(qa0), rb1 = s5_rowbase(qa1);
        bf16x8 a0[16], a1[16];
#pragma unroll
        for (int kk = 0; kk < 8; ++kk) { a0[kk] = *(const bf16x8*)(z + (size_t)(rb0 + kk * 2 + (fq >> 1)) * ZLD + ZC_U5 + g * 16 + (fq & 1) * 8);
            a1[kk] = *(const bf16x8*)(z + (size_t)(rb1 + kk * 2 + (fq >> 1)) * ZLD + ZC_U5 + g * 16 + (fq & 1) * 8); }
#pragma unroll
        for (int kk = 0; kk < 8; ++kk) { const int d = kk >> 2;
            a0[8 + kk] = *(const bf16x8*)(xe + ((size_t)((d * 4 + qa0 / 528) * 528 + qa0 % 528) * 16 + g) * 128 + (kk & 3) * 32 + fq * 8);
            a1[8 + kk] = *(const bf16x8*)(xe + ((size_t)((d * 4 + qa1 / 528) * 528 + qa1 % 528) * 16 + g) * 128 + (kk & 3) * 32 + fq * 8); }
        bf16_t* orow0 = g5 + (size_t)rb0 * 256 + g * 16 + fq * 4; bf16_t* orow1 = g5 + (size_t)rb1 * 256 + g * 16 + fq * 4;
#pragma unroll 1
        for (int hf = 0; hf < 2; ++hf) {
            __syncthreads();
#pragma unroll 1
            for (int k0 = 0; k0 < 16; k0 += 8) { u32x4 st_[8];
#pragma unroll
                for (int k = 0; k < 8; ++k) { const int i = tid + (k0 + k) * NTHR, r = i >> 6, c = i & 63; st_[k] = *(const u32x4*)(mc + (size_t)(hf * 128 + r) * 1024 + c * 16); }
#pragma unroll
                for (int k = 0; k < 8; ++k) { const int i = tid + (k0 + k) * NTHR, r = i >> 6, c = i & 63; *(u32x4*)(smem + r * RS + c * 16) = st_[k]; } }
            __syncthreads();
#pragma unroll 1
            for (int tt = 0; tt < 8; ++tt) {
                f32x4 acc0 = {0.f, 0.f, 0.f, 0.f}, acc1 = {0.f, 0.f, 0.f, 0.f};
#pragma unroll
                for (int kk = 0; kk < 16; ++kk) { const bf16x8 bb = *(const bf16x8*)(smem + (tt * 16 + fr) * RS + kk * 64 + fq * 16); acc0 = mfma16(bb, a0[kk], acc0); acc1 = mfma16(bb, a1[kk], acc1); }
                const int t = hf * 8 + tt;
                if (on0) { u32x2 w; w.x = pk2(gelu_tanh(acc0[0]), gelu_tanh(acc0[1])); w.y = pk2(gelu_tanh(acc0[2]), gelu_tanh(acc0[3])); *(u32x2*)(orow0 + (size_t)t * 256) = w; }
                if (on1) { u32x2 w; w.x = pk2(gelu_tanh(acc1[0]), gelu_tanh(acc1[1])); w.y = pk2(gelu_tanh(acc1[2]), gelu_tanh(acc1[3])); *(u32x2*)(orow1 + (size_t)t * 256) = w; }
            }
        }
    }
    __syncthreads();
}

#define XB_TMO      128
#define XB_XCNT(j)  (256  + 64 * (j))
#define XB_XSUB(j)  (1280 + 64 * (j))
#define XB_XGEN(j)  (2304 + 64 * (j))
#define XB_TOP      3328
#define XB_TOPGEN   3392
#define XCD_BAR_WORDS 3456
#define XB_SPIN_CAP (1u << 22)
__device__ __forceinline__ unsigned xb_ld(unsigned* p)              { return __hip_atomic_load(p, __ATOMIC_RELAXED, __HIP_MEMORY_SCOPE_AGENT); }
__device__ __forceinline__ unsigned xb_add(unsigned* p, unsigned v) { return __hip_atomic_fetch_add(p, v, __ATOMIC_RELAXED, __HIP_MEMORY_SCOPE_AGENT); }
__device__ __forceinline__ unsigned xb_xcc_id() { return (unsigned)__builtin_amdgcn_s_getreg((3 << 11) | 20) & 0xFu; }
#define XB_SPIN(cond, bar) do { unsigned _sp = 0; while (cond) { __builtin_amdgcn_s_sleep(1); \
    if ((++_sp & 255u) == 0u) { if (xb_ld(&(bar)[XB_TMO])) break; if (_sp > XB_SPIN_CAP) { atomicAdd(&(bar)[XB_TMO], 1u); break; } } } } while (0)
struct XcdBarrier { unsigned* bar; unsigned x; volatile LAS unsigned* st; };
__device__ __forceinline__ XcdBarrier xcd_barrier_post(unsigned* bar, volatile LAS unsigned* st) {
    XcdBarrier b; b.bar = bar; b.x = xb_xcc_id(); b.st = st;
    if (threadIdx.x == 0) (void)xb_add(&bar[XB_XCNT(b.x)], 1u);
    return b;
}
__device__ __forceinline__ void xcd_barrier_complete(unsigned* bar, unsigned x, unsigned& nloc, unsigned& nx) {
    const unsigned G = gridDim.x * gridDim.y * gridDim.z;
    unsigned sum, cnt, mine, sp = 0u;
    for (;;) {
        sum = 0u; cnt = 0u; mine = 0u;
#pragma unroll
        for (unsigned j = 0; j < 16; ++j) { const unsigned c = xb_ld(&bar[XB_XCNT(j)]); sum += c; cnt += (c > 0u) ? 1u : 0u; mine = (j == x) ? c : mine; }
        if (sum == G) break;
        __builtin_amdgcn_s_sleep(1);
        if ((++sp & 255u) == 0u) { if (xb_ld(&bar[XB_TMO])) break; if (sp > XB_SPIN_CAP) { atomicAdd(&bar[XB_TMO], 1u); break; } }
    }
    nloc = mine > 0u ? mine : 1u; nx = cnt > 0u ? cnt : 1u;
}
__device__ __forceinline__ void xcd_barrier(const XcdBarrier& b) {
    asm volatile("s_waitcnt vmcnt(0)" ::: "memory");
    __syncthreads();
    if (threadIdx.x == 0) {
        unsigned* bar = b.bar;
        __builtin_amdgcn_s_waitcnt(0);
        unsigned nloc = b.st[0], nx = b.st[1];
        if (nloc == 0u) { xcd_barrier_complete(bar, b.x, nloc, nx); b.st[0] = nloc; b.st[1] = nx; }
        const unsigned old = xb_add(&bar[XB_XSUB(b.x)], 1u);
        const unsigned gen = old / nloc;
        if (old + 1u == (gen + 1u) * nloc) {
            __builtin_amdgcn_fence(__ATOMIC_RELEASE, "agent");
            asm volatile("s_waitcnt vmcnt(0)" ::: "memory");
            const unsigned og = xb_add(&bar[XB_TOP], 1u);
            const unsigned tg = og / nx;
            if (og + 1u == (tg + 1u) * nx) xb_add(&bar[XB_TOPGEN], 1u);
            else XB_SPIN(xb_ld(&bar[XB_TOPGEN]) == tg, bar);
            __builtin_amdgcn_fence(__ATOMIC_ACQUIRE, "agent");
            xb_add(&bar[XB_XGEN(b.x)], 1u);
            asm volatile("s_waitcnt vmcnt(0)" ::: "memory");
        } else {
            XB_SPIN(xb_ld(&bar[XB_XGEN(b.x)]) == gen, bar);
            __builtin_amdgcn_fence(__ATOMIC_ACQUIRE, "agent");
            asm volatile("s_waitcnt vmcnt(0)" ::: "memory");
        }
    }
    __syncthreads();
}

__device__ __forceinline__ int walk_rowbase(int b, int d, int s) {
    if (d == 0) return s < 4 ? LROWS + b * 256 + s * 64 : b * 8192 + (s - 4) * 64;
    return s < 4 ? LROWS + b * 256 + (3 - s) * 64 : b * 8192 + (131 - s) * 64;
}
constexpr int HALF_LDS = 75 * 1024;

#define LBAR() do { asm volatile("s_waitcnt lgkmcnt(0)" ::: "memory"); __builtin_amdgcn_s_barrier(); asm volatile("" ::: "memory"); } while (0)
#define SCAT8(dst, str, VV_) do { (dst)[0 * (str)] = (bf16_t)((VV_).x & 0xFFFF); (dst)[1 * (str)] = (bf16_t)((VV_).x >> 16); (dst)[2 * (str)] = (bf16_t)((VV_).y & 0xFFFF); (dst)[3 * (str)] = (bf16_t)((VV_).y >> 16); \
        (dst)[4 * (str)] = (bf16_t)((VV_).z & 0xFFFF); (dst)[5 * (str)] = (bf16_t)((VV_).z >> 16); (dst)[6 * (str)] = (bf16_t)((VV_).w & 0xFFFF); (dst)[7 * (str)] = (bf16_t)((VV_).w >> 16); } while (0)
__device__ __forceinline__ float fast_logsig(float x) { return fminf(x, 0.f) - __logf(1.0f + __expf(-fabsf(x))); }
__device__ __forceinline__ int chunk_rowbase(int cgi) { const int b = cgi / 132, j = cgi % 132; return j < 4 ? LROWS + b * 256 + j * 64 : b * 8192 + (j - 4) * 64; }
__device__ __forceinline__ int walk_cgi(int b, int d, int s) { return b * 132 + (d == 0 ? s : (s < 4 ? 3 - s : 135 - s)); }

typedef short s16x4 __attribute__((ext_vector_type(4)));
__device__ __forceinline__ bf16x8 tr_frag(const bf16_t* base, int rs, int c, int ks, int lane) {
    const int g = lane >> 4, q = (lane & 15) >> 2, pp = lane & 3;
    const bf16_t* a0 = base + (32 * ks + 8 * g + q) * rs + 16 * c + 4 * pp;
    const s16x4 v0 = __builtin_amdgcn_ds_read_tr16_b64_v4i16((LAS s16x4*)(a0));
    const s16x4 v1 = __builtin_amdgcn_ds_read_tr16_b64_v4i16((LAS s16x4*)(a0 + 4 * rs));
    return (bf16x8){v0[0], v0[1], v0[2], v0[3], v1[0], v1[1], v1[2], v1[3]};
}

struct GlaPrepIn { u32x4 l0, l1, l2, l3, v[3]; u32x2 q[3], k[3]; };
__device__ __forceinline__ void gla_prep_load(PRM p, int job, int tid, GlaPrepIn& in) {
    const int h = job & 3, d = (job >> 2) & 1, cgi = job >> 3, rbase = chunk_rowbase(cgi);
    const bf16_t* __restrict__ z = (const bf16_t*)(p.big + BIG_Z);
    const int r = tid >> 2, c4 = tid & 3;
    const bf16_t* zr = z + (size_t)(rbase + r) * ZLD;
    in.l0 = *(const u32x4*)(zr + ZC_GLR); in.l1 = *(const u32x4*)(zr + ZC_GLR + 8); in.l2 = *(const u32x4*)(zr + ZC_GLR + 16); in.l3 = *(const u32x4*)(zr + ZC_GLR + 24); (void)d;
#pragma unroll
    for (int i = 0; i < 3; ++i) { in.q[i] = *(const u32x2*)(zr + ZC_GQ + h * 48 + c4 * 12 + i * 4); in.k[i] = *(const u32x2*)(zr + ZC_GK + h * 48 + c4 * 12 + i * 4); }
#pragma unroll
    for (int j = 0; j < 3; ++j) { const int i = tid + 256 * j, ro_ = i / 12, c8 = i % 12; in.v[j] = *(const u32x4*)(z + (size_t)(rbase + ro_) * ZLD + ZC_GV + h * 96 + c8 * 8); }
}
__device__ void gla_prep_job(PRM p, int l, int job, unsigned char* hl, int tid, const GlaPrepIn& in) {
    const int h = job & 3, d = (job >> 2) & 1, cgi = job >> 3, rbase = chunk_rowbase(cgi);
    const int wv = tid >> 6, lane = tid & 63, fr = lane & 15, fq = lane >> 4;
    float* LG = (float*)hl; float* WA = LG + 64 * 49; float* BA = WA + 768;
    bf16_t* QD = (bf16_t*)(hl + 20480);
    bf16_t* KD = QD + 64 * 72;
    bf16_t* ATT = KD + 64 * 72;
    bf16_t* V = ATT + 64 * 72;
    const bf16_t* z = (const bf16_t*)(p.big + BIG_Z);
    bf16_t* QDg = (bf16_t*)((unsigned char*)p.A1 + A1_QD); bf16_t* KDg = (bf16_t*)((unsigned char*)p.A1 + A1_KD); float* BLg = (float*)((unsigned char*)p.A1 + A1_BL);
    bf16_t* ob = (bf16_t*)(p.big + BIG_OBUF) + (size_t)d * MROWS * 768;
    LBAR();
    const int r = tid >> 2, c4 = tid & 3, row = rbase + r, li = d ? 63 - r : r;
    const u32x4 l0 = d ? in.l2 : in.l0, l1 = d ? in.l3 : in.l1;
    WA += d * 816; BA += d * 816;
    u32x2 qv[3], kv[3];
#pragma unroll
    for (int i = 0; i < 3; ++i) { qv[i] = in.q[i]; kv[i] = in.k[i]; }
#pragma unroll
    for (int j = 0; j < 3; ++j) { const int i = tid + 256 * j, ro_ = i / 12, c8 = i % 12;
        *(u32x4*)(V + (d ? 63 - ro_ : ro_) * 104 + c8 * 8) = in.v[j]; }
    LBAR();
    {
        float lr[16];
        lr[0] = lo2f(l0.x); lr[1] = hi2f(l0.x); lr[2] = lo2f(l0.y); lr[3] = hi2f(l0.y); lr[4] = lo2f(l0.z); lr[5] = hi2f(l0.z); lr[6] = lo2f(l0.w); lr[7] = hi2f(l0.w);
        lr[8] = lo2f(l1.x); lr[9] = hi2f(l1.x); lr[10] = lo2f(l1.y); lr[11] = hi2f(l1.y); lr[12] = lo2f(l1.z); lr[13] = hi2f(l1.z); lr[14] = lo2f(l1.w); lr[15] = hi2f(l1.w);
#pragma unroll 4
        for (int kq = 0; kq < 12; ++kq) { const int k = c4 * 12 + kq; float zz = BA[k];
#pragma unroll
            for (int rr = 0; rr < 16; ++rr) zz += lr[rr] * WA[rr * 48 + k];
            LG[li * 49 + k] = fast_logsig(zz) * (1.0f / 16.0f); }
    }
    LBAR();
    if (tid < 48) { float run = 0.f;
#pragma unroll 16
        for (int ss = 0; ss < 64; ++ss) { run += LG[ss * 49 + tid]; LG[ss * 49 + tid] = run; }
        BLg[((size_t)(cgi * 2 + d) * 4 + h) * 48 + tid] = run; }
    LBAR();
    {
        float qf[12], kf[12];
#pragma unroll
        for (int i = 0; i < 3; ++i) { qf[i * 4] = lo2f(qv[i].x); qf[i * 4 + 1] = hi2f(qv[i].x); qf[i * 4 + 2] = lo2f(qv[i].y); qf[i * 4 + 3] = hi2f(qv[i].y);
            kf[i * 4] = lo2f(kv[i].x); kf[i * 4 + 1] = hi2f(kv[i].x); kf[i * 4 + 2] = lo2f(kv[i].y); kf[i * 4 + 3] = hi2f(kv[i].y); }
#pragma unroll
        for (int kq = 0; kq < 12; ++kq) { const float bq = LG[li * 49 + c4 * 12 + kq]; qf[kq] *= __expf(bq); kf[kq] *= __expf(-bq); }
        bf16_t* qo = QDg + ((size_t)row * 2 + d) * 192 + h * 48 + c4 * 12; bf16_t* ko = KDg + ((size_t)row * 2 + d) * 192 + h * 48 + c4 * 12;
#pragma unroll
        for (int i = 0; i < 3; ++i) { u32x2 w; w.x = pk2(qf[i * 4], qf[i * 4 + 1]); w.y = pk2(qf[i * 4 + 2], qf[i * 4 + 3]); *(u32x2*)(qo + i * 4) = w; *(u32x2*)(QD + li * 72 + c4 * 12 + i * 4) = w;
            u32x2 w2; w2.x = pk2(kf[i * 4], kf[i * 4 + 1]); w2.y = pk2(kf[i * 4 + 2], kf[i * 4 + 3]); *(u32x2*)(ko + i * 4) = w2; *(u32x2*)(KD + li * 72 + c4 * 12 + i * 4) = w2; }
    }
    LBAR();
    {
        f32x4 acc[4];
#pragma unroll
        for (int st = 0; st < 4; ++st) acc[st] = (f32x4){0.f, 0.f, 0.f, 0.f};
#pragma unroll
        for (int kk = 0; kk < 2; ++kk) { const bf16x8 a = *(const bf16x8*)(QD + (wv * 16 + fr) * 72 + kk * 32 + fq * 8);
#pragma unroll
            for (int st = 0; st < 4; ++st) if (st <= wv) { const bf16x8 bb = *(const bf16x8*)(KD + (st * 16 + fr) * 72 + kk * 32 + fq * 8); acc[st] = mfma16(a, bb, acc[st]); } }
#pragma unroll
        for (int st = 0; st < 4; ++st) { const int sidx = st * 16 + fr;
#pragma unroll
            for (int jj = 0; jj < 4; ++jj) { const int t = wv * 16 + fq * 4 + jj; const float pv = (st <= wv && sidx <= t) ? acc[st][jj] : 0.f; ATT[t * 72 + sidx] = f2bf(pv); } }
    }
    LBAR();
    {
        const bf16x8 b0 = *(const bf16x8*)(ATT + (wv * 16 + fr) * 72 + fq * 8), b1 = *(const bf16x8*)(ATT + (wv * 16 + fr) * 72 + 32 + fq * 8);
        const int t = wv * 16 + fr; bf16_t* orow = ob + (size_t)(rbase + (d ? 63 - t : t)) * 768 + h * 96 + fq * 4;
#pragma unroll
        for (int vt = 0; vt < 6; ++vt) { f32x4 acc = {0.f, 0.f, 0.f, 0.f};
            acc = mfma16(tr_frag(V, 104, vt, 0, lane), b0, acc); acc = mfma16(tr_frag(V, 104, vt, 1, lane), b1, acc);
            u32x2 w; w.x = pk2(acc[0], acc[1]); w.y = pk2(acc[2], acc[3]); *(u32x2*)(orow + vt * 16) = w; }
    }
}
struct MlPrepIn { u32x4 q[3], k[3], v[3]; bf16_t ig[2], fg[2]; };
__device__ __forceinline__ void ml_prep_load(PRM p, int job, int tid, MlPrepIn& in) {
    const int h = job & 3, d = (job >> 2) & 1, cgi = job >> 3, rbase = chunk_rowbase(cgi);
    const bf16_t* __restrict__ z = (const bf16_t*)(p.big + BIG_Z);
#pragma unroll
    for (int j = 0; j < 3; ++j) { const int i = tid + 256 * j, ro_ = i / 12, c8 = i % 12; const bf16_t* zz = z + (size_t)(rbase + ro_) * ZLD + h * 96 + c8 * 8;
        in.q[j] = *(const u32x4*)(zz + ZC_MQ); in.k[j] = *(const u32x4*)(zz + ZC_MK); in.v[j] = *(const u32x4*)(zz + ZC_MV); }
    in.ig[0] = 0; in.fg[0] = 0; in.ig[1] = 0; in.fg[1] = 0; (void)d;
    if (tid < 64) { const bf16_t* z0 = z + (size_t)(rbase + tid) * ZLD; const bf16_t* z1 = z + (size_t)(rbase + 63 - tid) * ZLD;
        in.ig[0] = z0[ZC_MIG + h]; in.fg[0] = z0[ZC_MFG + h]; in.ig[1] = z1[ZC_MIG + 4 + h]; in.fg[1] = z1[ZC_MFG + 4 + h]; }
}
__device__ void ml_prep_job(PRM p, int l, int job, unsigned char* hl, int tid, const MlPrepIn& in) {
    const int h = job & 3, d = (job >> 2) & 1, cgi = job >> 3, rbase = chunk_rowbase(cgi);
    const int wv = tid >> 6, lane = tid & 63, fr = lane & 15, fq = lane >> 4;
    bf16_t* Q = (bf16_t*)hl;
    bf16_t* Kk = Q + 64 * 104;
    bf16_t* V = Kk + 64 * 104;
    bf16_t* P = V + 64 * 104;
    float* CS = (float*)(P + 64 * 72); float* PM = CS + 64; float* ES = PM + 64;
    const bf16_t* z = (const bf16_t*)(p.big + BIG_Z);
    float* G4 = (float*)((unsigned char*)p.A1 + A1_G4); float* CH = (float*)((unsigned char*)p.A1 + A1_CH); float* DN = (float*)((unsigned char*)p.A1 + A1_DN); float* DIg = (float*)((unsigned char*)p.A1 + A1_DI);
    bf16_t* ob = (bf16_t*)(p.big + BIG_OBUF) + (size_t)d * MROWS * 768;
    LBAR();
#pragma unroll
    for (int j = 0; j < 3; ++j) { const int i = tid + 256 * j, ro_ = i / 12, c8 = i % 12, lo_ = (d ? 63 - ro_ : ro_) * 104 + c8 * 8;
        *(u32x4*)(Q + lo_) = in.q[j]; *(u32x4*)(Kk + lo_) = in.k[j]; *(u32x4*)(V + lo_) = in.v[j]; }
    if (wv == 0) {
        const int row = rbase + (d ? 63 - lane : lane);
        const float ig = bf2f(d ? in.ig[1] : in.ig[0]) + p.ml_i_bias[(l * 2 + d) * 4 + h];
        const float lf = fast_logsig(bf2f(d ? in.fg[1] : in.fg[0]) + p.ml_f_bias[(l * 2 + d) * 4 + h]);
        float F = lf;
#pragma unroll
        for (int o = 1; o < 64; o <<= 1) { const float t = __shfl_up(F, o, 64); if (lane >= o) F += t; }
        const float F_last = __shfl(F, 63, 64);
        const float gg = F_last - F + ig;
        const float m_loc = wave_max(gg);
        const float cs = ig - F;
        float pm = cs;
#pragma unroll
        for (int o = 1; o < 64; o <<= 1) { const float t = __shfl_up(pm, o, 64); if (lane >= o) pm = fmaxf(pm, t); }
        *(f32x4*)(G4 + (((size_t)row * 2 + d) * 4 + h) * 4) = (f32x4){F, cs, pm, gg};
        CS[lane] = cs; PM[lane] = pm; ES[lane] = __expf(gg - m_loc);
        if (lane == 0) { CH[((cgi * 2 + d) * 4 + h) * 2] = F_last; CH[((cgi * 2 + d) * 4 + h) * 2 + 1] = m_loc; }
    }
    LBAR();
    if (tid >= 128 && tid < 224) { const int k = tid - 128; float a0 = 0.f;
#pragma unroll 8
        for (int ss = 0; ss < 64; ++ss) a0 += ES[ss] * bf2f(Kk[ss * 104 + k]);
        DN[((size_t)(cgi * 2 + d) * 4 + h) * 96 + k] = a0; }
    {
        f32x4 acc[4];
#pragma unroll
        for (int st = 0; st < 4; ++st) acc[st] = (f32x4){0.f, 0.f, 0.f, 0.f};
#pragma unroll
        for (int kk = 0; kk < 3; ++kk) { const bf16x8 a = *(const bf16x8*)(Q + (wv * 16 + fr) * 104 + kk * 32 + fq * 8);
#pragma unroll
            for (int st = 0; st < 4; ++st) if (st <= wv) { const bf16x8 bb = *(const bf16x8*)(Kk + (st * 16 + fr) * 104 + kk * 32 + fq * 8); acc[st] = mfma16(a, bb, acc[st]); } }
        float rs[4] = {0.f, 0.f, 0.f, 0.f}, pmt[4];
#pragma unroll
        for (int jj = 0; jj < 4; ++jj) pmt[jj] = PM[wv * 16 + fq * 4 + jj];
#pragma unroll
        for (int st = 0; st < 4; ++st) { const int sidx = st * 16 + fr; const float cs = CS[sidx];
#pragma unroll
            for (int jj = 0; jj < 4; ++jj) { const int t = wv * 16 + fq * 4 + jj;
                float pv = 0.f; if (st <= wv && sidx <= t) pv = __expf(cs - pmt[jj]) * acc[st][jj];
                rs[jj] += pv; P[t * 72 + sidx] = f2bf(pv); } }
#pragma unroll
        for (int jj = 0; jj < 4; ++jj) { float v = rs[jj]; v += __shfl_xor(v, 1, 64); v += __shfl_xor(v, 2, 64); v += __shfl_xor(v, 4, 64); v += __shfl_xor(v, 8, 64);
            if (fr == 0) { const int t = wv * 16 + fq * 4 + jj; DIg[((size_t)(rbase + (d ? 63 - t : t)) * 2 + d) * 4 + h] = v; } }
    }
    LBAR();
    {
        const bf16x8 b0 = *(const bf16x8*)(P + (wv * 16 + fr) * 72 + fq * 8), b1 = *(const bf16x8*)(P + (wv * 16 + fr) * 72 + 32 + fq * 8);
        const int t = wv * 16 + fr; bf16_t* orow = ob + (size_t)(rbase + (d ? 63 - t : t)) * 768 + 384 + h * 96 + fq * 4;
#pragma unroll
        for (int vt = 0; vt < 6; ++vt) { f32x4 acc = {0.f, 0.f, 0.f, 0.f};
            acc = mfma16(tr_frag(V, 104, vt, 0, lane), b0, acc); acc = mfma16(tr_frag(V, 104, vt, 1, lane), b1, acc);
            u32x2 w; w.x = pk2(acc[0], acc[1]); w.y = pk2(acc[2], acc[3]); *(u32x2*)(orow + vt * 16) = w; }
    }
}
__device__ void phase_prep(const Ctx& cx, PRM p, int l, unsigned char* smem) {
    const int tid = cx.tid, half = tid >> 8, t2 = tid & 255;
    unsigned char* hl = smem + half * HALF_LDS;
    const int jp0 = (((cx.bid >> 4) << 3) + (cx.bid & 7)) * 2 + ((cx.bid >> 3) & 1);
    { bf16_t* QD = (bf16_t*)(hl + 20480); LBAR(); for (int i = t2; i < 2 * 64 * 72; i += 256) QD[i] = 0;
        const int h = (jp0 * 2 + half) & 3;
        float* WA = (float*)hl + 64 * 49;
        for (int i = t2; i < 2 * 816; i += 256) { const int d = i / 816, j = i % 816;
            WA[i] = j < 768 ? p.gla_w_a2[((size_t)(l * 2 + d) * 16 + j / 48) * 192 + h * 48 + j % 48] : p.gla_b_a[(l * 2 + d) * 192 + h * 48 + (j - 768)]; } }
    {
        GlaPrepIn nxt; int jp = jp0;
        if (jp < 1056) gla_prep_load(p, ((jp * 2 + half) >> 2) * 8 + ((jp * 2 + half) & 3), t2, nxt);
        while (jp < 1056) { const GlaPrepIn cur = nxt; const int jn = jp + cx.nb; const int jq = jp * 2 + half, jb = (jq >> 2) * 8 + (jq & 3);
            if (jn < 1056) gla_prep_load(p, (((jn * 2 + half) >> 2) * 8) + ((jn * 2 + half) & 3), t2, nxt);
#pragma unroll 1
            for (int d = 0; d < 2; ++d) gla_prep_job(p, l, jb + d * 4, hl, t2, cur);
            jp = jn; }
    }
    {
        MlPrepIn nxt; int jp = jp0;
        if (jp < 1056) ml_prep_load(p, ((jp * 2 + half) >> 2) * 8 + ((jp * 2 + half) & 3), t2, nxt);
        while (jp < 1056) { const MlPrepIn cur = nxt; const int jn = jp + cx.nb; const int jq = jp * 2 + half, jb = (jq >> 2) * 8 + (jq & 3);
            if (jn < 1056) ml_prep_load(p, (((jn * 2 + half) >> 2) * 8) + ((jn * 2 + half) & 3), t2, nxt);
#pragma unroll 1
            for (int d = 0; d < 2; ++d) ml_prep_job(p, l, jb + d * 4, hl, t2, cur);
            jp = jn; }
    }
}

__device__ void mlstm_walk(PRM p, int l, int job, unsigned char* hl, int tid, const int seg, const int mode) {
    const int chain = job / 3, slice = job % 3, d = chain >> 4, b = (chain >> 2) & 3, h = chain & 3;
    const int wv = tid >> 6, lane = tid & 63, fr = lane & 15, fq = lane >> 4;
    bf16_t* Q = (bf16_t*)hl;
    bf16_t* Kk = Q + 64 * 104;
    bf16_t* VW = Kk + 64 * 104;
    bf16_t* CT = VW + 64 * 40;
    float* fa = (float*)(CT + 2 * 32 * 104);
    float* WI = fa; float* RR = fa + 64; float* EM = fa + 128; float* DIQ = fa + 192; float* QN = fa + 256; float* NE = fa + 320; float* SC = fa + 416;
    const bf16_t* z = (const bf16_t*)(p.big + BIG_Z);
    const float* G4 = (const float*)((const unsigned char*)p.A1 + A1_G4); const float* CH = (const float*)((const unsigned char*)p.A1 + A1_CH);
    const float* DN = (const float*)((const unsigned char*)p.A1 + A1_DN); const float* DIg = (const float*)((const unsigned char*)p.A1 + A1_DI);
    bf16_t* ob = (bf16_t*)(p.big + BIG_OBUF) + (size_t)d * MROWS * 768;
    f32x4 cacc[3];
#pragma unroll
    for (int i = 0; i < 3; ++i) cacc[i] = (f32x4){0.f, 0.f, 0.f, 0.f};
    const int vt_s = wv & 1, kt0 = (wv >> 1) * 3;
    const int s_begin = seg * 44, s_end = s_begin + 44;
    float* MLS = (float*)((unsigned char*)p.A1 + A1_MLS); float* MLN = (float*)((unsigned char*)p.A1 + A1_MLN);
    float m_state = (mode == 0 && seg > 0) ? -1e30f : 0.f, f_acc = 0.f, n_reg = 0.f;
    for (int i = tid; i < 2 * 32 * 104; i += 256) CT[i] = 0;
    if (mode == 1) {
        for (int sp = 0; sp < seg; ++sp) {
            const float* sm = MLS + ((size_t)(job * 2 + sp) * 256 + tid) * 12; const float* sn = MLN + (size_t)(job * 2 + sp) * 128;
            const float Fs = sn[97], ms = sn[96];
            const float mn = fmaxf(Fs + m_state, ms), aa = __expf(Fs + m_state - mn), bb2 = __expf(ms - mn);
#pragma unroll
            for (int i = 0; i < 3; ++i) { const f32x4 cs4 = *(const f32x4*)(sm + i * 4); cacc[i] = cacc[i] * aa + cs4 * bb2; }
            if (tid < 96) n_reg = aa * n_reg + bb2 * sn[tid];
            m_state = mn;
        }
        LBAR();
        bf16_t* CT0 = CT + (s_begin & 1) * 32 * 104;
#pragma unroll
        for (int i = 0; i < 3; ++i)
#pragma unroll
            for (int jj = 0; jj < 4; ++jj) CT0[(vt_s * 16 + fq * 4 + jj) * 104 + (kt0 + i) * 16 + fr] = f2bf(cacc[i][jj]);
    }
    if (tid < 96) NE[tid] = n_reg;
    int lo[3], go[3];
#pragma unroll
    for (int j = 0; j < 3; ++j) { const int i = tid + 256 * j, r = i / 12, c8 = i % 12; lo[j] = r * 104 + c8 * 8; go[j] = (d ? 63 - r : r) * ZLD + h * 96 + c8 * 8; }
    const int vr_ = tid >> 2, vc8 = tid & 3, vrow = d ? 63 - vr_ : vr_;
    const int grow = d ? 63 - lane : lane;
    const int trow = d ? 63 - (wv * 16 + fr) : (wv * 16 + fr);
    const int ocol = 384 + h * 96 + slice * 32 + fq * 4;
    u32x4 rq[3], rk[3], rv; f32x4 rg4 = {0.f, 0.f, 0.f, 0.f}; float rgv = 0.f, rfl = 0.f, rml = 0.f, rdn = 0.f, rdi = 0.f; u32x2 ro[2];
#define ML_LOAD(ss) do { const int cgi_ = walk_cgi(b, d, (ss)); const int rb_ = chunk_rowbase(cgi_); const bf16_t* zb = z + (size_t)rb_ * ZLD; \
        _Pragma("unroll") for (int j = 0; j < 3; ++j) { if (mode == 1) rq[j] = *(const u32x4*)(zb + go[j] + ZC_MQ); rk[j] = *(const u32x4*)(zb + go[j] + ZC_MK); } \
        rv = *(const u32x4*)(zb + (size_t)vrow * ZLD + ZC_MV + h * 96 + slice * 32 + vc8 * 8); \
        rgv = G4[(((size_t)(rb_ + vrow) * 2 + d) * 4 + h) * 4 + 3]; rml = CH[((cgi_ * 2 + d) * 4 + h) * 2 + 1]; \
        if (wv == 0) { rg4 = *(const f32x4*)(G4 + (((size_t)(rb_ + grow) * 2 + d) * 4 + h) * 4); rfl = CH[((cgi_ * 2 + d) * 4 + h) * 2]; rdi = DIg[((size_t)(rb_ + grow) * 2 + d) * 4 + h]; } \
        if (tid < 96) rdn = DN[((size_t)(cgi_ * 2 + d) * 4 + h) * 96 + tid]; \
        if (mode == 1) { const bf16_t* op_ = ob + (size_t)(rb_ + trow) * 768 + ocol; ro[0] = *(const u32x2*)(op_); ro[1] = *(const u32x2*)(op_ + 16); } } while (0)
    for (int j = 0; j < 3; ++j) rq[j] = (u32x4){0u, 0u, 0u, 0u};
    ro[0] = (u32x2){0u, 0u}; ro[1] = (u32x2){0u, 0u};
    ML_LOAD(s_begin);
    for (int s = s_begin; s < s_end; ++s) {
        const int rbase = chunk_rowbase(walk_cgi(b, d, s));
        bf16_t* CTc = CT + (s & 1) * 32 * 104; bf16_t* CTn = CT + ((s + 1) & 1) * 32 * 104;
        LBAR();
#pragma unroll
        for (int j = 0; j < 3; ++j) { if (mode == 1) *(u32x4*)(Q + lo[j]) = rq[j]; *(u32x4*)(Kk + lo[j]) = rk[j]; }
        { const float er = __expf(rgv - rml); u32x4 w;
            w.x = pk2(lo2f(rv.x) * er, hi2f(rv.x) * er); w.y = pk2(lo2f(rv.y) * er, hi2f(rv.y) * er); w.z = pk2(lo2f(rv.z) * er, hi2f(rv.z) * er); w.w = pk2(lo2f(rv.w) * er, hi2f(rv.w) * er);
            *(u32x4*)(VW + vr_ * 40 + vc8 * 8) = w; }
        const float dn_cur = rdn;
        float oin[8];
        oin[0] = lo2f(ro[0].x); oin[1] = hi2f(ro[0].x); oin[2] = lo2f(ro[0].y); oin[3] = hi2f(ro[0].y); oin[4] = lo2f(ro[1].x); oin[5] = hi2f(ro[1].x); oin[6] = lo2f(ro[1].y); oin[7] = hi2f(ro[1].y);
        if (wv == 0) {
            const float F = rg4[0], pm = rg4[2];
            const float mx = fmaxf(m_state, pm);
            const float m_new_ = fmaxf(rfl + m_state, rml);
            WI[lane] = __expf(m_state - mx); RR[lane] = __expf(pm - mx); EM[lane] = __expf(-(F + mx)); DIQ[lane] = rdi;
            if (lane == 0) { SC[0] = __expf(rfl + m_state - m_new_); SC[1] = m_new_; SC[2] = __expf(rml - m_new_); }
            f_acc += rfl;
        }
        if (s + 1 < s_end) ML_LOAD(s + 1);
        LBAR();
        const float alpha = SC[0], m_new = SC[1], beta = SC[2];
        if (mode == 1) {
            const int t = tid >> 2, part = tid & 3; float sacc = 0.f;
#pragma unroll
            for (int k8 = 0; k8 < 3; ++k8) { const u32x4 qv = *(const u32x4*)(Q + t * 104 + part * 24 + k8 * 8); const f32x4 n0 = *(const f32x4*)(NE + part * 24 + k8 * 8), n1 = *(const f32x4*)(NE + part * 24 + k8 * 8 + 4);
                sacc += lo2f(qv.x) * n0[0] + hi2f(qv.x) * n0[1] + lo2f(qv.y) * n0[2] + hi2f(qv.y) * n0[3] + lo2f(qv.z) * n1[0] + hi2f(qv.z) * n1[1] + lo2f(qv.w) * n1[2] + hi2f(qv.w) * n1[3]; }
            sacc += __shfl_xor(sacc, 1, 64); sacc += __shfl_xor(sacc, 2, 64);
            if (part == 0) QN[t] = sacc; }
        __builtin_amdgcn_s_setprio(1);
        f32x4 a1[2];
#pragma unroll
        for (int vt = 0; vt < 2; ++vt) a1[vt] = (f32x4){0.f, 0.f, 0.f, 0.f};
        if (mode == 1)
#pragma unroll
        for (int kk = 0; kk < 3; ++kk) { const bf16x8 bq = *(const bf16x8*)(Q + (wv * 16 + fr) * 104 + kk * 32 + fq * 8);
#pragma unroll
            for (int vt = 0; vt < 2; ++vt) { const bf16x8 ac = *(const bf16x8*)(CTc + (vt * 16 + fr) * 104 + kk * 32 + fq * 8); a1[vt] = mfma16(ac, bq, a1[vt]); } }
        {
            const bf16x8 av0 = tr_frag(VW, 40, vt_s, 0, lane), av1 = tr_frag(VW, 40, vt_s, 1, lane);
#pragma unroll
            for (int i = 0; i < 3; ++i) { f32x4 tacc = {0.f, 0.f, 0.f, 0.f};
                tacc = mfma16(av0, tr_frag(Kk, 104, kt0 + i, 0, lane), tacc); tacc = mfma16(av1, tr_frag(Kk, 104, kt0 + i, 1, lane), tacc);
                cacc[i] = cacc[i] * alpha + tacc * beta;
#pragma unroll
                for (int jj = 0; jj < 4; ++jj) CTn[(vt_s * 16 + fq * 4 + jj) * 104 + (kt0 + i) * 16 + fr] = f2bf(cacc[i][jj]); }
        }
        __builtin_amdgcn_s_setprio(0);
        if (mode == 1) LBAR();
        if (mode == 1) { const int t = wv * 16 + fr; const float wi = WI[t], rr = RR[t];
            const float den = wi * QN[t] + rr * DIQ[t]; const float dnm = fmaxf(fabsf(den), EM[t]); const float inv = __builtin_amdgcn_rcpf(dnm);
            bf16_t* op = ob + (size_t)(rbase + trow) * 768 + ocol;
#pragma unroll
            for (int vt = 0; vt < 2; ++vt) { u32x2 w;
                w.x = pk2((wi * a1[vt][0] + rr * oin[vt * 4 + 0]) * inv, (wi * a1[vt][1] + rr * oin[vt * 4 + 1]) * inv);
                w.y = pk2((wi * a1[vt][2] + rr * oin[vt * 4 + 2]) * inv, (wi * a1[vt][3] + rr * oin[vt * 4 + 3]) * inv);
                *(u32x2*)(op + vt * 16) = w; } }
        if (tid < 96) NE[tid] = alpha * NE[tid] + beta * dn_cur;
        m_state = m_new;
    }
    if (mode == 0) {
        LBAR();
        float* sm = MLS + ((size_t)(job * 2 + seg) * 256 + tid) * 12; float* sn = MLN + (size_t)(job * 2 + seg) * 128;
#pragma unroll
        for (int i = 0; i < 3; ++i) *(f32x4*)(sm + i * 4) = cacc[i];
        if (tid < 96) sn[tid] = NE[tid];
        if (tid == 0) { sn[96] = m_state; sn[97] = f_acc; }
    }
#undef ML_LOAD
}

__device__ void gla_walk(PRM p, int l, int job, unsigned char* hl, int tid, const int seg, const int mode) {
    const int chain = job / 3, slice = job % 3, d = chain >> 4, b = (chain >> 2) & 3, h = chain & 3;
    const int wv = tid >> 6, lane = tid & 63, fr = lane & 15, fq = lane >> 4;
    bf16_t* QD = (bf16_t*)hl;
    bf16_t* KD = QD + 64 * 72;
    bf16_t* V = KD + 64 * 72;
    bf16_t* ST = V + 64 * 40;
    float* BL = (float*)(ST + 2 * 32 * 72);
    const bf16_t* z = (const bf16_t*)(p.big + BIG_Z);
    const bf16_t* QDg = (const bf16_t*)((const unsigned char*)p.A1 + A1_QD); const bf16_t* KDg = (const bf16_t*)((const unsigned char*)p.A1 + A1_KD); const float* BLg = (const float*)((const unsigned char*)p.A1 + A1_BL);
    bf16_t* ob = (bf16_t*)(p.big + BIG_OBUF) + (size_t)d * MROWS * 768;
    for (int i = tid; i < 2 * 64 * 72; i += 256) QD[i] = 0;
    for (int i = tid; i < 2 * 32 * 72; i += 256) ST[i] = 0;
    f32x4 sacc[2];
    sacc[0] = (f32x4){0.f, 0.f, 0.f, 0.f}; sacc[1] = (f32x4){0.f, 0.f, 0.f, 0.f};
    const int vt_s = wv & 1, kt0 = (wv >> 1) * 2, nkt = (wv >> 1) == 0 ? 2 : 1;
    const int s_begin = seg * 66, s_end = s_begin + 66;
    float* GLS = (float*)((unsigned char*)p.A1 + A1_GLS) + ((size_t)job * 256 + tid) * 8;
    if (mode == 1 && seg == 1) {
        sacc[0] = *(const f32x4*)(GLS); sacc[1] = *(const f32x4*)(GLS + 4);
        LBAR();
        bf16_t* ST0 = ST + (s_begin & 1) * 32 * 72;
#pragma unroll
        for (int i = 0; i < 2; ++i) if (i < nkt) {
#pragma unroll
            for (int jj = 0; jj < 4; ++jj) ST0[(vt_s * 16 + fq * 4 + jj) * 72 + (kt0 + i) * 16 + fr] = f2bf(sacc[i][jj]); }
    }
    int lo[3]; size_t go[3]; const bf16_t* gsrc[3];
#pragma unroll
    for (int j = 0; j < 3; ++j) { const int i = tid + 256 * j, wh = i / 384, ii = i % 384, r = ii / 6, c8 = ii % 6;
        lo[j] = wh * 64 * 72 + r * 72 + c8 * 8; go[j] = ((size_t)(d ? 63 - r : r) * 2 + d) * 192 + h * 48 + c8 * 8; gsrc[j] = wh ? KDg : QDg; }
    const int vr_ = tid >> 2, vc8 = tid & 3, vrow = d ? 63 - vr_ : vr_;
    const int trow = d ? 63 - (wv * 16 + fr) : (wv * 16 + fr);
    const int ocol = h * 96 + slice * 32 + fq * 4;
    u32x4 rqk[3], rv; float rbl = 0.f; u32x2 ro[2];
#define GL_LOAD(ss) do { const int cgi_ = walk_cgi(b, d, (ss)); const int rb_ = chunk_rowbase(cgi_); \
        _Pragma("unroll") for (int j = 0; j < 3; ++j) if (mode == 1 || lo[j] >= 64 * 72) rqk[j] = *(const u32x4*)(gsrc[j] + (size_t)rb_ * 384 + go[j]); \
        rv = *(const u32x4*)(z + (size_t)(rb_ + vrow) * ZLD + ZC_GV + h * 96 + slice * 32 + vc8 * 8); \
        if (tid < 48) rbl = BLg[((size_t)(cgi_ * 2 + d) * 4 + h) * 48 + tid]; \
        if (mode == 1) { const bf16_t* op_ = ob + (size_t)(rb_ + trow) * 768 + ocol; ro[0] = *(const u32x2*)(op_); ro[1] = *(const u32x2*)(op_ + 16); } } while (0)
    for (int j = 0; j < 3; ++j) rqk[j] = (u32x4){0u, 0u, 0u, 0u};
    ro[0] = (u32x2){0u, 0u}; ro[1] = (u32x2){0u, 0u};
    GL_LOAD(s_begin);
    for (int s = s_begin; s < s_end; ++s) {
        const int rbase = chunk_rowbase(walk_cgi(b, d, s));
        bf16_t* STc = ST + (s & 1) * 32 * 72; bf16_t* STn = ST + ((s + 1) & 1) * 32 * 72;
        LBAR();
#pragma unroll
        for (int j = 0; j < 3; ++j) if (mode == 1 || lo[j] >= 64 * 72) *(u32x4*)(QD + lo[j]) = rqk[j];
        *(u32x4*)(V + vr_ * 40 + vc8 * 8) = rv;
        if (tid < 48) BL[tid] = rbl;
        float oin[8];
        oin[0] = lo2f(ro[0].x); oin[1] = hi2f(ro[0].x); oin[2] = lo2f(ro[0].y); oin[3] = hi2f(ro[0].y); oin[4] = lo2f(ro[1].x); oin[5] = hi2f(ro[1].x); oin[6] = lo2f(ro[1].y); oin[7] = hi2f(ro[1].y);
        if (s + 1 < s_end) GL_LOAD(s + 1);
        LBAR();
        __builtin_amdgcn_s_setprio(1);
        if (mode == 1) {
            f32x4 a1[2];
#pragma unroll
            for (int vt = 0; vt < 2; ++vt) a1[vt] = (f32x4){0.f, 0.f, 0.f, 0.f};
#pragma unroll
            for (int kk = 0; kk < 2; ++kk) { const bf16x8 bq = *(const bf16x8*)(QD + (wv * 16 + fr) * 72 + kk * 32 + fq * 8);
#pragma unroll
                for (int vt = 0; vt < 2; ++vt) { const bf16x8 as = *(const bf16x8*)(STc + (vt * 16 + fr) * 72 + kk * 32 + fq * 8); a1[vt] = mfma16(as, bq, a1[vt]); } }
            bf16_t* op = ob + (size_t)(rbase + trow) * 768 + ocol;
#pragma unroll
            for (int vt = 0; vt < 2; ++vt) { u32x2 w; w.x = pk2(a1[vt][0] + oin[vt * 4 + 0], a1[vt][1] + oin[vt * 4 + 1]); w.y = pk2(a1[vt][2] + oin[vt * 4 + 2], a1[vt][3] + oin[vt * 4 + 3]); *(u32x2*)(op + vt * 16) = w; }
        }
        {
            const bf16x8 av0 = tr_frag(V, 40, vt_s, 0, lane), av1 = tr_frag(V, 40, vt_s, 1, lane);
#pragma unroll
            for (int i = 0; i < 2; ++i) if (i < nkt) { const int kt = kt0 + i;
                sacc[i] = mfma16(av0, tr_frag(KD, 72, kt, 0, lane), sacc[i]); sacc[i] = mfma16(av1, tr_frag(KD, 72, kt, 1, lane), sacc[i]);
                sacc[i] *= __expf(BL[kt * 16 + fr]);
#pragma unroll
                for (int jj = 0; jj < 4; ++jj) STn[(vt_s * 16 + fq * 4 + jj) * 72 + kt * 16 + fr] = f2bf(sacc[i][jj]); }
        }
        __builtin_amdgcn_s_setprio(0);
    }
    if (mode == 0) { *(f32x4*)(GLS) = sacc[0]; *(f32x4*)(GLS + 4) = sacc[1]; }
#undef GL_LOAD
}

__device__ void phase_walks(const Ctx& cx, PRM p, int l, unsigned char* smem, int pass) {
    const int blk = cx.bid, tid = cx.tid, half = tid >> 8;
    unsigned char* hl = smem + half * HALF_LDS;
    int mixer = -1, rb = 0;
    if (pass == 0) { if (blk < 96) { mixer = 1; rb = blk; } else if (blk < 144) { mixer = 0; rb = blk - 96; } else mixer = 4; }
    else { if (blk < 144) { mixer = 1; rb = blk; } else if (blk < 240) { mixer = 0; rb = blk - 144; } else mixer = 2; }
    const int slot = 2 * (rb >> 3) + half, pr = (slot / 3) * 8 + (rb & 7);
    const int job = (pr & 31) * 3 + slot % 3, seg = pr >> 5;
    if (mixer == 1) mlstm_walk(p, l, job, hl, tid & 255, seg, pass);
    else if (mixer == 0) gla_walk(p, l, job, hl, tid & 255, seg, pass);
    else if (mixer == 2) { const int w = (blk - 240) * 8 + (tid >> 6); if (w < 128) s5_carry(p, l, w, tid & 63); }
    else if (mixer == 4) { Ctx c2 = cx; asm volatile("" : "+v"(c2.tid)); phase_s5a(c2, p, l, smem, 144); }
}

struct PostIn { u32x2 a[3], b[3], g[3]; };
__device__ __forceinline__ void post_load(PRM p, int row, int lane, PostIn& in) {
    const bf16_t* __restrict__ z = (const bf16_t*)(p.big + BIG_Z);
    const bf16_t* __restrict__ of = (const bf16_t*)(p.big + BIG_OBUF) + (size_t)row * 768 + lane * 12;
    const bf16_t* __restrict__ obk = of + (size_t)MROWS * 768;
    const bf16_t* __restrict__ gt = z + (size_t)row * ZLD + (lane >= 32 ? ZC_MO : ZC_GR) + (lane & 31) * 12;
#pragma unroll
    for (int i = 0; i < 3; ++i) { in.a[i] = *(const u32x2*)(of + i * 4); in.b[i] = *(const u32x2*)(obk + i * 4); in.g[i] = *(const u32x2*)(gt + i * 4); }
}
__device__ __forceinline__ void post_finish(PRM p, int l, int row, int lane, const PostIn& in) {
    float v[12];
#pragma unroll
    for (int i = 0; i < 3; ++i) { const u32x2 a = in.a[i], b = in.b[i];
        v[i * 4 + 0] = lo2f(a.x) + lo2f(b.x); v[i * 4 + 1] = hi2f(a.x) + hi2f(b.x); v[i * 4 + 2] = lo2f(a.y) + lo2f(b.y); v[i * 4 + 3] = hi2f(a.y) + hi2f(b.y); }
    float s = 0.f;
#pragma unroll
    for (int i = 0; i < 12; ++i) s += v[i];
    s += __shfl_xor(s, 1, 64); s += __shfl_xor(s, 2, 64); s += __shfl_xor(s, 4, 64);
    const float mu = s * (1.0f / 96.0f);
    float q = 0.f;
#pragma unroll
    for (int i = 0; i < 12; ++i) { const float dd = v[i] - mu; q += dd * dd; }
    q += __shfl_xor(q, 1, 64); q += __shfl_xor(q, 2, 64); q += __shfl_xor(q, 4, 64);
    const float rstd = rsqrtf(q * (1.0f / 96.0f) + 1e-5f);
    const bool isml = lane >= 32;
    const int c0 = (lane & 31) * 12;
    const float* gw = (isml ? p.ml_g : p.gla_g) + l * 384 + c0;
    bf16_t* dst = p.A1 + (size_t)row * 1024 + 256 + lane * 12;
#pragma unroll
    for (int i = 0; i < 3; ++i) { const u32x2 gv = in.g[i];
        float gg[4] = {lo2f(gv.x), hi2f(gv.x), lo2f(gv.y), hi2f(gv.y)}; float o[4];
#pragma unroll
        for (int j = 0; j < 4; ++j) { const float gate = isml ? sigmoidf_(gg[j]) : siluf_(gg[j]); o[j] = gate * ((v[i * 4 + j] - mu) * rstd * gw[i * 4 + j]); }
        u32x2 w; w.x = pk2(o[0], o[1]); w.y = pk2(o[2], o[3]); *(u32x2*)(dst + i * 4) = w; }
}
__device__ void phase_s5c_post(const Ctx& cx, PRM p, int l, unsigned char* smem) {
    const int wid = cx.tid >> 6, lane = cx.tid & 63;
    phase_s5c(cx, p, l, smem);
    {
        constexpr int POST_SPLIT = 22528;
        const bool free_wg = cx.bid >= 144;
        const int lo_ = free_wg ? 0 : POST_SPLIT, hi_ = free_wg ? POST_SPLIT : MROWS;
        const int step_ = (free_wg ? (cx.nb - 144) : 144) * 8;
        int row = lo_ + (free_wg ? cx.bid - 144 : cx.bid) * 8 + wid; PostIn cur, nxt;
        if (row < hi_) post_load(p, row, lane, cur);
        while (row < hi_) { const int rn = row + step_; if (rn < hi_) post_load(p, rn, lane, nxt); post_finish(p, l, row, lane, cur); cur = nxt; row = rn; }
    }
}


__device__ void phase_glu(const Ctx& cx, PRM p, int l, unsigned char* smem) {
    const int tid = cx.tid, wid = tid >> 6, lane = tid & 63, fr = lane & 15, fq = lane >> 4;
    const bf16_t* __restrict__ g5 = (const bf16_t*)(p.big + BIG_G5);
    const unsigned char* __restrict__ wg = (const unsigned char*)(p.WgluT + (size_t)l * 256 * 256);
    const float* __restrict__ bias = p.s5_b_glu + l * 256;
    bf16_t* __restrict__ A1 = p.A1;
    constexpr int RS = 528;
    __syncthreads();
    { u32x4 st_[16];
#pragma unroll
        for (int k = 0; k < 16; ++k) { const int i = tid + k * NTHR, r = i >> 5, c = i & 31; st_[k] = *(const u32x4*)(wg + (size_t)r * 512 + c * 16); }
#pragma unroll
        for (int k = 0; k < 16; ++k) { const int i = tid + k * NTHR, r = i >> 5, c = i & 31; *(u32x4*)(smem + r * RS + c * 16) = st_[k]; } }
    __syncthreads();
    for (int job = cx.bid * 8 + wid; job < MROWS / 16; job += cx.nb * 8) {
        const int row = job * 16 + fr;
        const bf16_t* gr = g5 + (size_t)row * 256;
        bf16x8 a[8]; u32x2 yv[16];
#pragma unroll
        for (int kk = 0; kk < 8; ++kk) a[kk] = *(const bf16x8*)(gr + kk * 32 + fq * 8);
#pragma unroll
        for (int n = 0; n < 16; ++n) yv[n] = *(const u32x2*)(gr + n * 16 + fq * 4);
#pragma unroll
        for (int ntl = 0; ntl < 16; ++ntl) {
            const f32x4 bs = *(const f32x4*)(bias + ntl * 16 + fq * 4);
            f32x4 acc = {0.f, 0.f, 0.f, 0.f};
#pragma unroll
            for (int kk = 0; kk < 8; ++kk) { const bf16x8 b = *(const bf16x8*)(smem + (ntl * 16 + fr) * RS + kk * 64 + fq * 16); acc = mfma16(b, a[kk], acc); }
            const u32x2 y2 = yv[ntl];
            u32x2 w; w.x = pk2(lo2f(y2.x) * sigmoidf_(acc[0] + bs[0]), hi2f(y2.x) * sigmoidf_(acc[1] + bs[1])); w.y = pk2(lo2f(y2.y) * sigmoidf_(acc[2] + bs[2]), hi2f(y2.y) * sigmoidf_(acc[3] + bs[3]));
            *(u32x2*)(A1 + (size_t)row * 1024 + ntl * 16 + fq * 4) = w;
            asm volatile("" ::: "memory");
        }
    }
    __syncthreads();
}

__device__ __forceinline__ void unpack8(const u32x4 w, float (&f)[8]) { f[0] = lo2f(w.x); f[1] = hi2f(w.x); f[2] = lo2f(w.y); f[3] = hi2f(w.y); f[4] = lo2f(w.z); f[5] = hi2f(w.z); f[6] = lo2f(w.w); f[7] = hi2f(w.w); }
__device__ void phase_conv(const Ctx& cx, PRM p, int l, unsigned char* smem) {
    const bf16_t* a = (const bf16_t*)(p.big + BIG_A);
    bf16_t* vg = (bf16_t*)(p.big + BIG_V);
    const float* wd = p.w_dconv + (size_t)l * 9 * DFF; const float* bd = p.b_dconv + (size_t)l * DFF;
    const int nseg = (l == 1) ? 1024 : 1056;
    long total = (long)nseg * 352, it0 = (long)cx.bid * NTHR + cx.tid, istep = (long)cx.nb * NTHR;
    if (l == 0) {
        if (cx.bid < 16) { it0 = 1024L * 352 + (long)cx.bid * NTHR + cx.tid; istep = 16L * NTHR; }
        else { total = 1024L * 352; it0 = (long)(cx.bid - 16) * NTHR + cx.tid; istep = (long)(cx.nb - 16) * NTHR; }
    }
    for (long it = it0; it < total; it += istep) {
        const int seg = (int)(it / 352), c0 = (int)(it % 352) * 8;
        int base, x0, W; bool up, dn;
        if (seg < 1024) { base = seg * 32; x0 = (seg & 1) * 32; W = 64; const int y = (seg >> 1) & 127; up = y > 0; dn = y < 127; }
        else { const int sc = seg - 1024; base = LROWS + sc * 32; x0 = (sc & 7) * 32; W = 256; up = false; dn = false; }
        float wgt[9][8], bias[8];
#pragma unroll
        for (int t = 0; t < 9; ++t) { const f32x4 w0 = *(const f32x4*)(wd + t * DFF + c0), w1 = *(const f32x4*)(wd + t * DFF + c0 + 4);
            wgt[t][0] = w0[0]; wgt[t][1] = w0[1]; wgt[t][2] = w0[2]; wgt[t][3] = w0[3]; wgt[t][4] = w1[0]; wgt[t][5] = w1[1]; wgt[t][6] = w1[2]; wgt[t][7] = w1[3]; }
        { const f32x4 b0 = *(const f32x4*)(bd + c0), b1 = *(const f32x4*)(bd + c0 + 4); bias[0] = b0[0]; bias[1] = b0[1]; bias[2] = b0[2]; bias[3] = b0[3]; bias[4] = b1[0]; bias[5] = b1[1]; bias[6] = b1[2]; bias[7] = b1[3]; }
        const u32x4 zero4 = {0u, 0u, 0u, 0u};
        const bf16_t* __restrict__ ac = a + (size_t)base * DFF + c0;
        bf16_t* __restrict__ vp = vg + (size_t)base * DFF + c0;
        u32x4 win[3][3], pre[3];
#pragma unroll
        for (int r = 0; r < 3; ++r) win[0][r] = zero4;
        if (x0 > 0) { win[0][1] = *(const u32x4*)(ac - (size_t)DFF); if (up) win[0][0] = *(const u32x4*)(ac - (size_t)65 * DFF); if (dn) win[0][2] = *(const u32x4*)(ac + (size_t)63 * DFF); }
        win[1][0] = up ? *(const u32x4*)(ac - (size_t)64 * DFF) : zero4; win[1][1] = *(const u32x4*)(ac); win[1][2] = dn ? *(const u32x4*)(ac + (size_t)64 * DFF) : zero4;
        { const bool h1 = (x0 + 1) < W; const bf16_t* a1 = ac + (size_t)DFF;
            win[2][0] = (h1 && up) ? *(const u32x4*)(a1 - (size_t)64 * DFF) : zero4; win[2][1] = h1 ? *(const u32x4*)(a1) : zero4; win[2][2] = (h1 && dn) ? *(const u32x4*)(a1 + (size_t)64 * DFF) : zero4; }
        u32x4 vcur = *(const u32x4*)(vp), vnxt = zero4;
        for (int i = 0; i < 32; ++i) {
            const bool has2 = (x0 + i + 2) < W;
            const bf16_t* an = ac + (size_t)(i + 2) * DFF;
            pre[0] = (has2 && up) ? *(const u32x4*)(an - (size_t)64 * DFF) : zero4;
            pre[1] = has2 ? *(const u32x4*)(an) : zero4;
            pre[2] = (has2 && dn) ? *(const u32x4*)(an + (size_t)64 * DFF) : zero4;
            if (i + 1 < 32) vnxt = *(const u32x4*)(vp + (size_t)(i + 1) * DFF);
            float acc[8];
#pragma unroll
            for (int e = 0; e < 8; ++e) acc[e] = bias[e];
#pragma unroll
            for (int r = 0; r < 3; ++r)
#pragma unroll
                for (int cdx = 0; cdx < 3; ++cdx) { float f[8]; unpack8(win[cdx][r], f);
#pragma unroll
                    for (int e = 0; e < 8; ++e) acc[e] += f[e] * wgt[r * 3 + cdx][e]; }
            float vf[8]; unpack8(vcur, vf);
            u32x4 o;
            o.x = pk2(gelu_tanh(acc[0]) * vf[0], gelu_tanh(acc[1]) * vf[1]); o.y = pk2(gelu_tanh(acc[2]) * vf[2], gelu_tanh(acc[3]) * vf[3]);
            o.z = pk2(gelu_tanh(acc[4]) * vf[4], gelu_tanh(acc[5]) * vf[5]); o.w = pk2(gelu_tanh(acc[6]) * vf[6], gelu_tanh(acc[7]) * vf[7]);
            *(u32x4*)(vp + (size_t)i * DFF) = o;
#pragma unroll
            for (int r = 0; r < 3; ++r) { win[0][r] = win[1][r]; win[1][r] = win[2][r]; win[2][r] = pre[r]; }
            vcur = vnxt;
        }
    }
    if (l == 0 && cx.bid < 16) {
        sub_barrier(cx, p.bar + 3648, 16u);
        pg8::EpiBf16 E; E.O = p.A1 + (size_t)LROWS * 1024; E.ldc = 1024; E.split_cols = 0; E.split_stride = 0;
        pg8::Gemm g; g.A = (const bf16_t*)(p.big + BIG_V) + (size_t)LROWS * DFF; g.Bt = p.WdownT; g.M = 1024; g.N = 1024; g.K = DFF;
        pg8::StaticOrder S; S.init(1024, 1024, 16, (int)cx.bid);
        pg8::gemm_phase<pg8::EpiBf16, pg8::StaticOrder>(cx, (LAS unsigned char*)smem, g, S, E);
    }
}

__device__ void run_phase(const Ctx& cx, PRM p, int ph, unsigned char* smem, const XcdBarrier& xb) {
    if (ph == 0) { phase0(cx, p, smem); return; }
    const int l = (ph - 1) / 12, q = (ph - 1) % 12;
    switch (q) {
        case 0: if (l == 0) phase_ln_first(cx, p); break;
        case 1: { pg8::EpiBf16 E; E.O = (bf16_t*)(p.big + BIG_Z); E.ldc = ZLD; E.split_cols = 0; E.split_stride = 0;
            run_gemm(cx, smem, p.A1, p.WinT + (size_t)l * 3072 * 1024, MROWS, 3072, 1024, E); } break;
        case 2: phase_prep(cx, p, l, smem); break;
        case 3:
#pragma unroll 1
            for (int pass = 0; pass < 2; ++pass) {
#if COOP
                if (pass) xcd_barrier(xb);
#endif
                phase_walks(cx, p, l, smem, pass); }
            break;
        case 4: phase_s5c_post(cx, p, l, smem); break;
        case 5: phase_glu(cx, p, l, smem); break;
        case 6: { pg8::EpiBf16 E; E.O = (bf16_t*)(p.big + BIG_Y); E.ldc = 1024; E.split_cols = 0; E.split_stride = 0;
            run_gemm(cx, smem, p.A1, p.WoutT + (size_t)l * 1024 * 1024, LROWS, 1024, 1024, E); } break;
        case 7: phase_ln_res(cx, p, l, 0, smem); break;
        case 8: { pg8::EpiBf16 E; E.O = (bf16_t*)(p.big + BIG_A); E.ldc = DFF; E.split_cols = DFF; E.split_stride = (size_t)MROWS * DFF;
            run_gemm(cx, smem, p.A1, p.WupT + (size_t)l * 5632 * 1024, l == 1 ? LROWS : MROWS, 5632, 1024, E); } break;
        case 9: phase_conv(cx, p, l, smem); break;
        case 10: { pg8::EpiBf16 E; E.O = (bf16_t*)(p.big + BIG_Y); E.ldc = 1024; E.split_cols = 0; E.split_stride = 0;
            run_gemm(cx, smem, (const bf16_t*)(p.big + BIG_V), p.WdownT + (size_t)l * 1024 * DFF, LROWS, 1024, DFF, E); } break;
        case 11: phase_ln_res(cx, p, l, 1, smem); break;
    }
}

__global__ void __launch_bounds__(512, 2) mega(Params p) {
    extern __shared__ __attribute__((aligned(16))) unsigned char smem[];
    bool first = true;
    XcdBarrier xb{};
#if COOP
    volatile LAS unsigned* xst = (volatile LAS unsigned*)(LAS unsigned char*)(smem + LDS_MAIN);
    if (threadIdx.x == 0) { xst[0] = 0u; xst[1] = 0u; }
    __syncthreads();
    xb = xcd_barrier_post(p.bar, xst);
#endif
#ifndef PROBE_DUP
#define PROBE_DUP 0
#endif
    int ph = p.ph_lo, rep = 0;
    while (ph < p.ph_hi) {
        if (ph == 13) { ++ph; continue; }
#if COOP
        if (!first) { if (p.ph_hi > 1000) cg::this_grid().sync(); else xcd_barrier(xb); }
#endif
        first = false;
        Ctx cx; { int t_ = threadIdx.x, b_ = blockIdx.x, n_ = gridDim.x; asm volatile("" : "+v"(t_)); asm volatile("" : "+s"(b_)); asm volatile("" : "+s"(n_)); cx.tid = t_; cx.bid = b_; cx.nb = n_; }
        const __attribute__((address_space(4))) Params* kp = (const __attribute__((address_space(4))) Params*)__builtin_amdgcn_kernarg_segment_ptr();
        asm volatile("" : "+s"(kp));
        run_phase(cx, *kp, ph, smem, xb);
        const int q_ = ph == 0 ? 12 : (ph - 1) % 12;
        const bool again = PROBE_DUP != 0 && rep == 0 && ((PROBE_DUP >> q_) & 1) && (ph <= 12 || !((PROBE_DUP >> 13) & 1));
        if (again) rep = 1; else { rep = 0; ++ph; }
    }
}

extern "C" void kernel_launch(void* const* d_in, const int* in_sizes, int n_in, void* d_out, int out_size, void* d_ws, size_t ws_size, hipStream_t stream) {
    static int grid = 0;
    if (grid == 0) {
        if (n_in != 32 || ws_size < WS_END) { fprintf(stderr, "kernel_launch: need 32 inputs and %zu bytes of workspace (got %d, %zu)\n", (size_t)WS_END, n_in, ws_size); grid = -1; return; }
        int dev = 0, cus = 0, per_cu = 0;
        (void)hipGetDevice(&dev); (void)hipDeviceGetAttribute(&cus, hipDeviceAttributeMultiprocessorCount, dev);
        if (hipFuncSetAttribute((const void*)mega, hipFuncAttributeMaxDynamicSharedMemorySize, LDS_BYTES) != hipSuccess) { fprintf(stderr, "kernel_launch: hipFuncSetAttribute failed\n"); grid = -1; return; }
        if (hipOccupancyMaxActiveBlocksPerMultiprocessor(&per_cu, (const void*)mega, NTHR, LDS_BYTES) != hipSuccess || per_cu < 1) { fprintf(stderr, "kernel_launch: occupancy query gave %d\n", per_cu); per_cu = 1; }
        (void)hipGetLastError();
        grid = cus * per_cu;
    }
    if (grid < 0) return;
    Params p{};
    const float** pin = (const float**)&p;
    for (int i = 0; i < 32; ++i) pin[i] = (const float*)d_in[i];
    unsigned char* ws = (unsigned char*)d_ws;
    p.out = (float*)d_out;
    p.WinT = (bf16_t*)(ws + WS_WIN); p.WoutT = (bf16_t*)(ws + WS_WOUT); p.WupT = (bf16_t*)(ws + WS_WUP); p.WdownT = (bf16_t*)(ws + WS_WDOWN); p.WgluT = (bf16_t*)(ws + WS_WGLU);
    p.mod = (float*)(ws + WS_MOD); p.M2T = (bf16_t*)(ws + WS_M2T); p.McatT = (bf16_t*)(ws + WS_MCAT); p.L16 = (float*)(ws + WS_L16); p.hc = (float*)(ws + WS_HC);
    p.A1 = (bf16_t*)(ws + WS_A1); p.big = ws + WS_BIG; p.bar = (unsigned*)(ws + WS_BAR);
    if (hipMemsetAsync(ws + WS_BAR, 0, 16384, stream) != hipSuccess) { fprintf(stderr, "kernel_launch: memset failed\n"); return; }
#if COOP
    p.ph_lo = 0; p.ph_hi = 25;
    void* args[] = {&p};
    hipError_t e = hipLaunchCooperativeKernel((const void*)mega, dim3(grid), dim3(NTHR), args, LDS_BYTES, stream);
    if (e != hipSuccess) fprintf(stderr, "cooperative launch failed: %s (grid %d)\n", hipGetErrorString(e), grid);
#else
    for (int ph = 0; ph < 25; ++ph) {
        if (ph == 13) continue;
        p.ph_lo = ph; p.ph_hi = ph + 1;
        hipLaunchKernelGGL(mega, dim3(grid), dim3(NTHR), LDS_BYTES, stream, p);
    }
#endif
}
```
